# Optimizing an MI355X kernel written in HIP

```python
import math
import jax, jax.numpy as jnp
from jax import lax
import numpy as np


D_MODEL = 1024
BATCH = 1
SEQ = 16384
DEPTH = 2
DEC_BATCH = 8
DEC_SEQ = 4096
PAST_LEN = 128

GRID_W = 64
GROUP_DIM = 16
N_GROUPS = D_MODEL // GROUP_DIM
STATE_DIM = 64
N_DIR = 2
N_HEADS = 16
HEAD_DIM = D_MODEL // N_HEADS
WIN_H = 8
WIN_W = 16
D_FF = ((8 * D_MODEL // 3 + 127) // 128) * 128
CONV_W = 3
N_MIXERS = 2
N_S5 = (DEPTH + 1) // 2
N_NA = DEPTH // 2
ALPHA = (2 * DEPTH) ** 0.25
BETA = (8 * DEPTH) ** -0.25
LN_EPS = 1e-5
DT_MIN = 1e-3
DT_MAX = 1e-1

kernel_name = 'hybrid_s5_natten_deepnorm_encoder'


def layer_norm(x, g, b):
    xf = x.astype(jnp.float32)
    mu = jnp.mean(xf, axis=-1, keepdims=True)
    var = jnp.mean(jnp.square(xf - mu), axis=-1, keepdims=True)
    y = (xf - mu) * lax.rsqrt(var + LN_EPS)
    return (y * g.astype(jnp.float32) + b.astype(jnp.float32)).astype(x.dtype)


def _cmul(ar, ai, br, bi):
    return ar * br - ai * bi, ar * bi + ai * br


def _ssm_combine(e1, e2):
    a1r, a1i, b1r, b1i = e1
    a2r, a2i, b2r, b2i = e2
    ar, ai = _cmul(a2r, a2i, a1r, a1i)
    br, bi = _cmul(a2r, a2i, b1r, b1i)
    return ar, ai, br + b2r, bi + b2i


def s5_direction(u, lam_re, lam_im, log_dt, b_re, b_im, c_re, c_im, reverse):
    dt = jnp.exp(log_dt)[:, None]
    z_re, z_im = lam_re * dt, lam_im * dt
    mag = jnp.exp(z_re)
    ab_re, ab_im = mag * jnp.cos(z_im), mag * jnp.sin(z_im)
    den = lam_re * lam_re + lam_im * lam_im
    nr, ni = ab_re - 1.0, ab_im
    f_re = (nr * lam_re + ni * lam_im) / den
    f_im = (ni * lam_re - nr * lam_im) / den
    bb_re = f_re[..., None] * b_re - f_im[..., None] * b_im
    bb_im = f_re[..., None] * b_im + f_im[..., None] * b_re
    bu_re = jnp.einsum('bsgh,gph->bsgp', u, bb_re)
    bu_im = jnp.einsum('bsgh,gph->bsgp', u, bb_im)
    a_re = jnp.broadcast_to(ab_re, bu_re.shape)
    a_im = jnp.broadcast_to(ab_im, bu_re.shape)
    _, _, s_re, s_im = lax.associative_scan(_ssm_combine, (a_re, a_im, bu_re, bu_im), axis=1, reverse=reverse)
    return jnp.einsum('bsgp,ghp->bsgh', s_re, c_re) - jnp.einsum('bsgp,ghp->bsgh', s_im, c_im)


def s5_mixer(h, lam_re, lam_im, log_dt, b_re, b_im, c_re, c_im, d_skip, w_glu, b_glu):
    bsz, slen, _ = h.shape
    f32 = jnp.float32
    u = h.astype(f32).reshape(bsz, slen, N_GROUPS, GROUP_DIM)
    y = d_skip.astype(f32) * u
    for d in range(N_DIR):
        y = y + s5_direction(u, lam_re[d].astype(f32), lam_im[d].astype(f32), log_dt[d].astype(f32),
                             b_re[d].astype(f32), b_im[d].astype(f32), c_re[d].astype(f32), c_im[d].astype(f32),
                             reverse=(d == 1))
    y = jax.nn.gelu(y.reshape(bsz, slen, D_MODEL)).astype(h.dtype)
    ag = y @ w_glu + b_glu
    a, g = jnp.split(ag, 2, axis=-1)
    return a * jax.nn.sigmoid(g)


def neighborhood_attention(h, w_qkv, b_qkv, rpb, w_o, b_o):
    bsz, slen, _ = h.shape
    rows = slen // GRID_W
    kh = min(WIN_H, rows)
    qkv = h @ w_qkv + b_qkv
    q, k, v = jnp.split(qkv, 3, axis=-1)
    grid = (bsz, rows, GRID_W, N_HEADS, HEAD_DIM)
    q = q.reshape(grid) * (HEAD_DIM ** -0.5)
    k = k.reshape(grid)
    v = v.reshape(grid)
    col = jnp.arange(GRID_W)
    col_start = jnp.clip(col - WIN_W // 2, 0, GRID_W - WIN_W)
    col_idx = col_start[:, None] + jnp.arange(WIN_W)[None, :]
    col_off = col_idx - col[:, None] + (WIN_W - 1)

    def one_row(r):
        rs = jnp.clip(r - kh // 2, 0, rows - kh)
        k_rows = lax.dynamic_slice_in_dim(k, rs, kh, axis=1)
        v_rows = lax.dynamic_slice_in_dim(v, rs, kh, axis=1)
        k_win = k_rows[:, :, col_idx]
        v_win = v_rows[:, :, col_idx]
        q_r = lax.dynamic_index_in_dim(q, r, axis=1, keepdims=False)
        s = jnp.einsum('bqhd,bkqwhd->bhqkw', q_r, k_win).astype(jnp.float32)
        row_off = rs + jnp.arange(kh) - r + (WIN_H - 1)
        bias = rpb.astype(jnp.float32)[:, row_off][:, :, col_off]
        s = s + jnp.transpose(bias, (0, 2, 1, 3))[None]
        p = jax.nn.softmax(s.reshape(bsz, N_HEADS, GRID_W, kh * WIN_W), axis=-1)
        p = p.reshape(bsz, N_HEADS, GRID_W, kh, WIN_W).astype(v.dtype)
        return jnp.einsum('bhqkw,bkqwhd->bqhd', p, v_win)

    o = lax.map(one_row, jnp.arange(rows))
    o = jnp.moveaxis(o, 0, 1).reshape(bsz, slen, D_MODEL)
    return o @ w_o + b_o


def conv_ffn(h, w_in, b_in, conv_w, conv_b, w_out, b_out):
    ug = h @ w_in + b_in
    u, g = jnp.split(ug, 2, axis=-1)
    up = jnp.pad(u, ((0, 0), (1, 1), (0, 0)))
    u = up[:, :-2] * conv_w[0] + up[:, 1:-1] * conv_w[1] + up[:, 2:] * conv_w[2] + conv_b
    return (jax.nn.gelu(u) * g) @ w_out + b_out


def encoder_trunk(x, c, w_ada, b_ada, ln_g, ln_b, s5_p, na_p, ffn_p):
    cond = jax.nn.silu(c)
    for i in range(DEPTH):
        mod = (cond @ w_ada[i] + b_ada[i])[:, None, :]
        sh_m, sc_m, g_m, sh_f, sc_f, g_f = jnp.split(mod, 6, axis=-1)
        h = x * (1.0 + sc_m) + sh_m
        j = i // N_MIXERS
        if i % N_MIXERS == 0:
            y = s5_mixer(h, *[p[j] for p in s5_p])
        else:
            y = neighborhood_attention(h, *[p[j] for p in na_p])
        x = layer_norm(ALPHA * x + g_m * y, ln_g[i, 0], ln_b[i, 0])
        h = x * (1.0 + sc_f) + sh_f
        y = conv_ffn(h, *[p[i] for p in ffn_p])
        x = layer_norm(ALPHA * x + g_f * y, ln_g[i, 1], ln_b[i, 1])
    return x


def setup_inputs(seed: int = 0) -> dict:
    key = jax.random.key(seed)
    ks = jax.random.split(key, 32)
    f32 = jnp.float32

    def nrm(k, shape, s):
        return s * jax.random.normal(k, shape, f32)

    D = D_MODEL
    n_idx = jnp.arange(STATE_DIM, dtype=f32)
    s5_shape = (N_S5, N_DIR, N_GROUPS, STATE_DIM)
    qkv_scale = jnp.concatenate([jnp.ones((2 * D,), f32), jnp.full((D,), BETA, f32)])
    return {
        'x_prompt': nrm(ks[0], (BATCH, SEQ, D), 1.0),
        'x_sample': nrm(ks[1], (DEC_BATCH, DEC_SEQ, D), 1.0),
        'c_prompt': nrm(ks[2], (BATCH, D), 1.0),
        'c_sample': nrm(ks[3], (DEC_BATCH, D), 1.0),
        'w_ada': nrm(ks[4], (DEPTH, D, 6 * D), 0.5 * D ** -0.5),
        'b_ada': nrm(ks[5], (DEPTH, 6 * D), 0.02),
        'ln_g': 1.0 + nrm(ks[6], (DEPTH, 2, D), 0.02),
        'ln_b': nrm(ks[7], (DEPTH, 2, D), 0.02),
        's5_lam_re': -0.5 + nrm(ks[8], s5_shape, 0.01),
        's5_lam_im': math.pi * n_idx + nrm(ks[9], s5_shape, 0.01),
        's5_log_dt': jax.random.uniform(ks[10], (N_S5, N_DIR, N_GROUPS), f32, math.log(DT_MIN), math.log(DT_MAX)),
        's5_b_re': nrm(ks[11], (N_S5, N_DIR, N_GROUPS, STATE_DIM, GROUP_DIM), (2 * GROUP_DIM) ** -0.5),
        's5_b_im': nrm(ks[12], (N_S5, N_DIR, N_GROUPS, STATE_DIM, GROUP_DIM), (2 * GROUP_DIM) ** -0.5),
        's5_c_re': nrm(ks[13], (N_S5, N_DIR, N_GROUPS, GROUP_DIM, STATE_DIM), (2 * STATE_DIM) ** -0.5),
        's5_c_im': nrm(ks[14], (N_S5, N_DIR, N_GROUPS, GROUP_DIM, STATE_DIM), (2 * STATE_DIM) ** -0.5),
        's5_d': nrm(ks[15], (N_S5, N_GROUPS, GROUP_DIM), 1.0),
        's5_w_glu': nrm(ks[16], (N_S5, D, 2 * D), BETA * D ** -0.5),
        's5_b_glu': nrm(ks[17], (N_S5, 2 * D), 0.02),
        'na_w_qkv': nrm(ks[18], (N_NA, D, 3 * D), D ** -0.5) * qkv_scale,
        'na_b_qkv': nrm(ks[19], (N_NA, 3 * D), 0.02),
        'na_rpb': nrm(ks[20], (N_NA, N_HEADS, 2 * WIN_H - 1, 2 * WIN_W - 1), 0.1),
        'na_w_o': nrm(ks[21], (N_NA, D, D), BETA * D ** -0.5),
        'na_b_o': nrm(ks[22], (N_NA, D), 0.02),
        'ffn_w_in': nrm(ks[23], (DEPTH, D, 2 * D_FF), D ** -0.5),
        'ffn_b_in': nrm(ks[24], (DEPTH, 2 * D_FF), 0.02),
        'ffn_conv_w': nrm(ks[25], (DEPTH, CONV_W, D_FF), CONV_W ** -0.5),
        'ffn_conv_b': nrm(ks[26], (DEPTH, D_FF), 0.02),
        'ffn_w_out': nrm(ks[27], (DEPTH, D_FF, D), BETA * D_FF ** -0.5),
        'ffn_b_out': nrm(ks[28], (DEPTH, D), 0.02),
    }


def reference(x_prompt, x_sample, c_prompt, c_sample, w_ada, b_ada, ln_g, ln_b,
              s5_lam_re, s5_lam_im, s5_log_dt, s5_b_re, s5_b_im, s5_c_re, s5_c_im, s5_d, s5_w_glu, s5_b_glu,
              na_w_qkv, na_b_qkv, na_rpb, na_w_o, na_b_o,
              ffn_w_in, ffn_b_in, ffn_conv_w, ffn_conv_b, ffn_w_out, ffn_b_out):
    s5_p = (s5_lam_re, s5_lam_im, s5_log_dt, s5_b_re, s5_b_im, s5_c_re, s5_c_im, s5_d, s5_w_glu, s5_b_glu)
    na_p = (na_w_qkv, na_b_qkv, na_rpb, na_w_o, na_b_o)
    ffn_p = (ffn_w_in, ffn_b_in, ffn_conv_w, ffn_conv_b, ffn_w_out, ffn_b_out)
    y_prompt = encoder_trunk(x_prompt, c_prompt, w_ada, b_ada, ln_g, ln_b, s5_p, na_p, ffn_p)
    y_sample = encoder_trunk(x_sample, c_sample, w_ada, b_ada, ln_g, ln_b, s5_p, na_p, ffn_p)
    return (y_prompt, y_sample)
```

```cpp
#include <hip/hip_runtime.h>
#include <math.h>
#include <cstdio>

constexpr int NTOK = 49152, D = 1024, NB = 9, DFF = 2816, NPROMPT = 16384, SSEQ = 4096;
constexpr float ALPHA = 1.41421356237309515f;
constexpr float LN_EPS = 1e-5f;

__device__ __host__ inline int tok_b(int t) { return t < NPROMPT ? 0 : 1 + ((t - NPROMPT) >> 12); }
__device__ __host__ inline int seq_start(int b) { return b == 0 ? 0 : NPROMPT + (b - 1) * SSEQ; }
__device__ __host__ inline int seq_len(int b) { return b == 0 ? NPROMPT : SSEQ; }
__device__ inline float gelu_tanh(float x) { const float u = 0.7978845608028654f * (x + 0.044715f * x * x * x); return 0.5f * x * (1.0f + tanhf(u)); }
__device__ inline float wave_sum(float v) { for (int o = 32; o >= 1; o >>= 1) v += __shfl_xor(v, o); return v; }

__global__ void nk_mods(const float* cp, const float* cs, const float* w_ada, const float* b_ada, float* mods) {
    __shared__ float cond[NB][D];
    for (int i = threadIdx.x; i < NB * D; i += 256) { const int b = i / D, k = i % D; const float c = b == 0 ? cp[k] : cs[(b - 1) * D + k]; cond[b][k] = c / (1.0f + expf(-c)); }
    __syncthreads();
    const int col = blockIdx.x * 256 + threadIdx.x, layer = col / 6144, n = col % 6144;
    float acc[NB];
    for (int b = 0; b < NB; ++b) acc[b] = 0.f;
    const float* w = w_ada + (size_t)layer * D * 6144 + n;
    for (int k = 0; k < D; ++k) { const float wv = w[(size_t)k * 6144]; for (int b = 0; b < NB; ++b) acc[b] += cond[b][k] * wv; }
    for (int b = 0; b < NB; ++b) mods[(size_t)(layer * NB + b) * 6144 + n] = acc[b] + b_ada[layer * 6144 + n];
}

__global__ void nk_ln_mod(const float* xp, const float* xs, const float* v, int use_ln, const float* lng, const float* lnb, const float* mods_l, int sh_off, int sc_off, float* H) {
    const int row = blockIdx.x * 4 + (threadIdx.x >> 6), lane = threadIdx.x & 63, b = tok_b(row);
    const float* src = use_ln ? v + (size_t)row * D : (row < NPROMPT ? xp + (size_t)row * D : xs + (size_t)(row - NPROMPT) * D);
    float4 x[4];
    for (int j = 0; j < 4; ++j) x[j] = *(const float4*)(src + j * 256 + lane * 4);
    if (use_ln) {
        float s = 0.f; for (int j = 0; j < 4; ++j) s += x[j].x + x[j].y + x[j].z + x[j].w;
        const float mean = wave_sum(s) * (1.0f / D);
        float q = 0.f; for (int j = 0; j < 4; ++j) { float d0 = x[j].x - mean, d1 = x[j].y - mean, d2 = x[j].z - mean, d3 = x[j].w - mean; q += d0 * d0 + d1 * d1 + d2 * d2 + d3 * d3; }
        const float rstd = rsqrtf(wave_sum(q) * (1.0f / D) + LN_EPS);
        for (int j = 0; j < 4; ++j) { const int n = j * 256 + lane * 4; const float4 g = *(const float4*)(lng + n), bb = *(const float4*)(lnb + n);
            x[j].x = (x[j].x - mean) * rstd * g.x + bb.x; x[j].y = (x[j].y - mean) * rstd * g.y + bb.y; x[j].z = (x[j].z - mean) * rstd * g.z + bb.z; x[j].w = (x[j].w - mean) * rstd * g.w + bb.w; }
    }
    const float* m = mods_l + (size_t)b * 6144;
    for (int j = 0; j < 4; ++j) { const int n = j * 256 + lane * 4; const float4 sc = *(const float4*)(m + sc_off * D + n), sh = *(const float4*)(m + sh_off * D + n);
        float4 o; o.x = x[j].x * (1.f + sc.x) + sh.x; o.y = x[j].y * (1.f + sc.y) + sh.y; o.z = x[j].z * (1.f + sc.z) + sh.z; o.w = x[j].w * (1.f + sc.w) + sh.w;
        *(float4*)(H + (size_t)row * D + n) = o; }
}

template <int ACT> __global__ void nk_gemm(const float* A, int lda, const float* W, int ldw, const float* bias, float* C, int ldc, int M, int N, int K) {
    __shared__ float As[16][68], Ws[16][64];
    const int tid = threadIdx.x, tx = tid & 15, ty = tid >> 4, m0 = blockIdx.y * 64, n0 = blockIdx.x * 64;
    float acc[4][4];
    for (int i = 0; i < 4; ++i) for (int j = 0; j < 4; ++j) acc[i][j] = 0.f;
    const int ar = tid >> 2, ak = (tid & 3) * 4; int arow = m0 + ar; if (arow >= M) arow = M - 1;
    const int wr = tid >> 4, wc = (tid & 15) * 4;
    for (int k0 = 0; k0 < K; k0 += 16) {
        float4 a = *(const float4*)(A + (size_t)arow * lda + k0 + ak);
        if (ACT == 1) { a.x = gelu_tanh(a.x); a.y = gelu_tanh(a.y); a.z = gelu_tanh(a.z); a.w = gelu_tanh(a.w); }
        const float4 w = *(const float4*)(W + (size_t)(k0 + wr) * ldw + n0 + wc);
        As[ak + 0][ar] = a.x; As[ak + 1][ar] = a.y; As[ak + 2][ar] = a.z; As[ak + 3][ar] = a.w;
        *(float4*)&Ws[wr][wc] = w;
        __syncthreads();
#pragma unroll
        for (int kk = 0; kk < 16; ++kk) { const float4 av = *(const float4*)&As[kk][ty * 4]; const float4 wv = *(const float4*)&Ws[kk][tx * 4];
            const float aa[4] = {av.x, av.y, av.z, av.w}, ww[4] = {wv.x, wv.y, wv.z, wv.w};
#pragma unroll
            for (int i = 0; i < 4; ++i)
#pragma unroll
                for (int j = 0; j < 4; ++j) acc[i][j] += aa[i] * ww[j]; }
        __syncthreads();
    }
    for (int i = 0; i < 4; ++i) { const int r = m0 + ty * 4 + i; if (r >= M) continue;
        float4 o; const int c = n0 + tx * 4; o.x = acc[i][0] + bias[c]; o.y = acc[i][1] + bias[c + 1]; o.z = acc[i][2] + bias[c + 2]; o.w = acc[i][3] + bias[c + 3];
        *(float4*)(C + (size_t)r * ldc + c) = o; }
}

__global__ void nk_dskip(const float* H, const float* d, float* Y) { const size_t i = (size_t)blockIdx.x * 256 + threadIdx.x; Y[i] = H[i] * d[i & (D - 1)]; }

__global__ void nk_s5_scan(const float* H, float* Y, int dir, const float* lam_re, const float* lam_im, const float* log_dt, const float* b_re, const float* b_im, const float* c_re, const float* c_im) {
    const int b = blockIdx.x / 64, g = blockIdx.x % 64, p = threadIdx.x;
    const int idx = (dir * 64 + g) * 64 + p;
    const double dt = exp((double)log_dt[dir * 64 + g]), lr = lam_re[idx], li = lam_im[idx];
    const double zr = lr * dt, zi = li * dt, mag = exp(zr), abr_d = mag * cos(zi), abi_d = mag * sin(zi);
    const double den = lr * lr + li * li, nr = abr_d - 1.0, ni = abi_d, fr = (nr * lr + ni * li) / den, fi = (ni * lr - nr * li) / den;
    float bbr[16], bbi[16], cr[16], ci[16];
    for (int h = 0; h < 16; ++h) { const double br = b_re[(size_t)idx * 16 + h], bi = b_im[(size_t)idx * 16 + h]; bbr[h] = (float)(fr * br - fi * bi); bbi[h] = (float)(fr * bi + fi * br);
        cr[h] = c_re[((size_t)(dir * 64 + g) * 16 + h) * 64 + p]; ci[h] = c_im[((size_t)(dir * 64 + g) * 16 + h) * 64 + p]; }
    const float abr = (float)abr_d, abi = (float)abi_d;
    const int s0 = seq_start(b), S = seq_len(b);
    float sr = 0.f, si = 0.f;
    for (int i = 0; i < S; ++i) {
        const int t = s0 + (dir == 0 ? i : S - 1 - i);
        const float* u = H + (size_t)t * D + g * 16;
        float bur = 0.f, bui = 0.f;
#pragma unroll
        for (int h = 0; h < 16; ++h) { const float uv = u[h]; bur += uv * bbr[h]; bui += uv * bbi[h]; }
        const float nsr = abr * sr - abi * si + bur, nsi = abr * si + abi * sr + bui; sr = nsr; si = nsi;
        float mine = 0.f;
#pragma unroll
        for (int h = 0; h < 16; ++h) { const float r = wave_sum(cr[h] * sr - ci[h] * si); if (p == h) mine = r; }
        if (p < 16) Y[(size_t)t * D + g * 16 + p] += mine;
    }
}

__global__ void nk_residual(const float* xp, const float* xs, float* vio, int use_ln, const float* lng, const float* lnb, const float* mods_l, int gate_off, const float* Ysrc, int glu, int row0, float* stats) {
    const int rc = blockIdx.x * 4 + (threadIdx.x >> 6), row = row0 + rc, lane = threadIdx.x & 63, b = tok_b(row);
    const float* src = use_ln ? vio + (size_t)row * D : (row < NPROMPT ? xp + (size_t)row * D : xs + (size_t)(row - NPROMPT) * D);
    float4 x[4];
    for (int j = 0; j < 4; ++j) x[j] = *(const float4*)(src + j * 256 + lane * 4);
    if (use_ln) {
        float s = 0.f; for (int j = 0; j < 4; ++j) s += x[j].x + x[j].y + x[j].z + x[j].w;
        const float mean = wave_sum(s) * (1.0f / D);
        float q = 0.f; for (int j = 0; j < 4; ++j) { float d0 = x[j].x - mean, d1 = x[j].y - mean, d2 = x[j].z - mean, d3 = x[j].w - mean; q += d0 * d0 + d1 * d1 + d2 * d2 + d3 * d3; }
        const float rstd = rsqrtf(wave_sum(q) * (1.0f / D) + LN_EPS);
        for (int j = 0; j < 4; ++j) { const int n = j * 256 + lane * 4; const float4 g = *(const float4*)(lng + n), bb = *(const float4*)(lnb + n);
            x[j].x = (x[j].x - mean) * rstd * g.x + bb.x; x[j].y = (x[j].y - mean) * rstd * g.y + bb.y; x[j].z = (x[j].z - mean) * rstd * g.z + bb.z; x[j].w = (x[j].w - mean) * rstd * g.w + bb.w; }
    }
    const float* gate = mods_l + (size_t)b * 6144 + gate_off * D;
    float s1 = 0.f, s2 = 0.f;
    for (int j = 0; j < 4; ++j) { const int n = j * 256 + lane * 4; float4 y;
        if (glu) { const float4 a = *(const float4*)(Ysrc + (size_t)rc * 2048 + n), g = *(const float4*)(Ysrc + (size_t)rc * 2048 + 1024 + n);
            y.x = a.x / (1.f + expf(-g.x)); y.y = a.y / (1.f + expf(-g.y)); y.z = a.z / (1.f + expf(-g.z)); y.w = a.w / (1.f + expf(-g.w)); }
        else y = *(const float4*)(Ysrc + (size_t)rc * D + n);
        const float4 gt = *(const float4*)(gate + n);
        float4 o; o.x = ALPHA * x[j].x + gt.x * y.x; o.y = ALPHA * x[j].y + gt.y * y.y; o.z = ALPHA * x[j].z + gt.z * y.z; o.w = ALPHA * x[j].w + gt.w * y.w;
        s1 += o.x + o.y + o.z + o.w; s2 += o.x * o.x + o.y * o.y + o.z * o.z + o.w * o.w;
        *(float4*)(vio + (size_t)row * D + n) = o; }
    s1 = wave_sum(s1); s2 = wave_sum(s2);
    if (lane == 0 && stats) { stats[row * 2] = s1; stats[row * 2 + 1] = s2; }
}

__global__ void nk_convgate(const float* UG, int ug0, int t0, int rows, const float* cw, const float* cb, float* Ac) {
    const size_t i = (size_t)blockIdx.x * 256 + threadIdx.x; if (i >= (size_t)rows * DFF) return;
    const int r = (int)(i / DFF), ch = (int)(i % DFF), t = t0 + r, b = tok_b(t), s0 = seq_start(b), s1 = s0 + seq_len(b);
    const float* u = UG + (size_t)(t - ug0) * (2 * DFF) + ch;
    const float up = (t - 1 >= s0) ? u[-(2 * DFF)] : 0.f, uc = u[0], un = (t + 1 < s1) ? u[2 * DFF] : 0.f;
    const float c = up * cw[ch] + uc * cw[DFF + ch] + un * cw[2 * DFF + ch] + cb[ch];
    Ac[(size_t)r * DFF + ch] = gelu_tanh(c) * u[DFF];
}

__global__ void nk_na_attn(const float* QKV, int kv0, int t0, const float* rpb, float* Oc) {
    const int wid = blockIdx.x * 4 + (threadIdx.x >> 6), lane = threadIdx.x & 63;
    const int r = wid >> 4, h = wid & 15, t = t0 + r, b = tok_b(t), s0 = seq_start(b), nrows = seq_len(b) / 64;
    const int tl = t - s0, gr = tl >> 6, gc = tl & 63;
    int rs = gr - 4; rs = rs < 0 ? 0 : (rs > nrows - 8 ? nrows - 8 : rs);
    int cs = gc - 8; cs = cs < 0 ? 0 : (cs > 48 ? 48 : cs);
    __shared__ float qs[4][64]; __shared__ float ps[4][128];
    const int w = threadIdx.x >> 6;
    qs[w][lane] = QKV[(size_t)(t - kv0) * 3072 + h * 64 + lane] * 0.125f;
    __syncthreads();
    float sc[2];
    for (int j = 0; j < 2; ++j) { const int kk = lane + j * 64, kr = rs + (kk >> 4), kc = cs + (kk & 15), kt = s0 + kr * 64 + kc;
        const float* kp = QKV + (size_t)(kt - kv0) * 3072 + 1024 + h * 64; float s = 0.f;
        for (int d = 0; d < 64; d += 4) { const float4 kv = *(const float4*)(kp + d); s += qs[w][d] * kv.x + qs[w][d + 1] * kv.y + qs[w][d + 2] * kv.z + qs[w][d + 3] * kv.w; }
        sc[j] = s + rpb[(h * 15 + (kr - gr + 7)) * 31 + (kc - gc + 15)]; }
    float m = fmaxf(sc[0], sc[1]); for (int o = 32; o >= 1; o >>= 1) m = fmaxf(m, __shfl_xor(m, o));
    const float e0 = expf(sc[0] - m), e1 = expf(sc[1] - m); const float sum = wave_sum(e0 + e1);
    ps[w][lane] = e0 / sum; ps[w][lane + 64] = e1 / sum;
    __syncthreads();
    float o = 0.f;
    for (int kk = 0; kk < 128; ++kk) { const int kr = rs + (kk >> 4), kc = cs + (kk & 15), kt = s0 + kr * 64 + kc; o += ps[w][kk] * QKV[(size_t)(kt - kv0) * 3072 + 2048 + h * 64 + lane]; }
    Oc[(size_t)r * D + h * 64 + lane] = o;
}

__global__ void nk_final_ln(float* v, const float* lng, const float* lnb) {
    const int row = blockIdx.x * 4 + (threadIdx.x >> 6), lane = threadIdx.x & 63;
    float4 x[4];
    for (int j = 0; j < 4; ++j) x[j] = *(const float4*)(v + (size_t)row * D + j * 256 + lane * 4);
    float s = 0.f; for (int j = 0; j < 4; ++j) s += x[j].x + x[j].y + x[j].z + x[j].w;
    const float mean = wave_sum(s) * (1.0f / D);
    float q = 0.f; for (int j = 0; j < 4; ++j) { float d0 = x[j].x - mean, d1 = x[j].y - mean, d2 = x[j].z - mean, d3 = x[j].w - mean; q += d0 * d0 + d1 * d1 + d2 * d2 + d3 * d3; }
    const float rstd = rsqrtf(wave_sum(q) * (1.0f / D) + LN_EPS);
    for (int j = 0; j < 4; ++j) { const int n = j * 256 + lane * 4; const float4 g = *(const float4*)(lng + n), bb = *(const float4*)(lnb + n);
        float4 o; o.x = (x[j].x - mean) * rstd * g.x + bb.x; o.y = (x[j].y - mean) * rstd * g.y + bb.y; o.z = (x[j].z - mean) * rstd * g.z + bb.z; o.w = (x[j].w - mean) * rstd * g.w + bb.w;
        *(float4*)(v + (size_t)row * D + n) = o; }
}

extern "C" void kernel_launch(void* const* d_in, const int* in_sizes, int n_in, void* d_out, int out_size, void* d_ws, size_t ws_size, hipStream_t stream) {
    const float* xp = (const float*)d_in[0]; const float* xs = (const float*)d_in[1]; const float* cp = (const float*)d_in[2]; const float* cs = (const float*)d_in[3];
    const float* w_ada = (const float*)d_in[4]; const float* b_ada = (const float*)d_in[5]; const float* ln_g = (const float*)d_in[6]; const float* ln_b = (const float*)d_in[7];
    const float* lam_re = (const float*)d_in[8]; const float* lam_im = (const float*)d_in[9]; const float* log_dt = (const float*)d_in[10];
    const float* b_re = (const float*)d_in[11]; const float* b_im = (const float*)d_in[12]; const float* c_re = (const float*)d_in[13]; const float* c_im = (const float*)d_in[14];
    const float* s5_d = (const float*)d_in[15]; const float* w_glu = (const float*)d_in[16]; const float* b_glu = (const float*)d_in[17];
    const float* w_qkv = (const float*)d_in[18]; const float* b_qkv = (const float*)d_in[19]; const float* rpb = (const float*)d_in[20]; const float* w_o = (const float*)d_in[21]; const float* b_o = (const float*)d_in[22];
    const float* w_in = (const float*)d_in[23]; const float* b_in = (const float*)d_in[24]; const float* conv_w = (const float*)d_in[25]; const float* conv_b = (const float*)d_in[26];
    const float* w_out = (const float*)d_in[27]; const float* b_out = (const float*)d_in[28];
    float* out = (float*)d_out; char* ws = (char*)d_ws;
    const size_t MB = 1ull << 20;
    if (ws_size < 410 * MB) { fprintf(stderr, "ws too small: %zu\n", ws_size); return; }
    float* H = (float*)(ws);
    float* R1 = (float*)(ws + 192 * MB);
    float* mods = (float*)(ws + 400 * MB);
    const int CH = 4096;

    nk_mods<<<48, 256, 0, stream>>>(cp, cs, w_ada, b_ada, mods);
    nk_ln_mod<<<NTOK / 4, 256, 0, stream>>>(xp, xs, nullptr, 0, nullptr, nullptr, mods, 0, 1, H);
    float* Y = R1;
    nk_dskip<<<NTOK * D / 256, 256, 0, stream>>>(H, s5_d, Y);
    nk_s5_scan<<<NB * 64, 64, 0, stream>>>(H, Y, 0, lam_re, lam_im, log_dt, b_re, b_im, c_re, c_im);
    nk_s5_scan<<<NB * 64, 64, 0, stream>>>(H, Y, 1, lam_re, lam_im, log_dt, b_re, b_im, c_re, c_im);
    for (int c0 = 0; c0 < NTOK; c0 += CH) {
        float* AG = H;
        nk_gemm<1><<<dim3(2048 / 64, CH / 64), 256, 0, stream>>>(Y + (size_t)c0 * D, D, w_glu, 2048, b_glu, AG, 2048, CH, 2048, D);
        nk_residual<<<CH / 4, 256, 0, stream>>>(xp, xs, out, 0, nullptr, nullptr, mods, 2, AG, 1, c0, nullptr);
    }
    for (int layer = 0; layer < 2; ++layer) {
        const float* mods_l = mods + (size_t)layer * NB * 6144;
        if (layer == 1) {
            const float* lg = ln_g + 1 * D; const float* lb = ln_b + 1 * D;
            nk_ln_mod<<<NTOK / 4, 256, 0, stream>>>(xp, xs, out, 1, lg, lb, mods_l, 0, 1, H);
            float* QKV = R1; float* Oc = R1 + (size_t)80 * MB / 4; float* Yc = R1 + (size_t)100 * MB / 4;
            for (int c0 = 0; c0 < NTOK; c0 += CH) {
                const int b = tok_b(c0), s0 = seq_start(b), s1 = s0 + seq_len(b);
                int k0 = c0 - 7 * 64; if (k0 < s0) k0 = s0; int k1 = c0 + CH + 7 * 64; if (k1 > s1) k1 = s1;
                const int kr = k1 - k0;
                nk_gemm<0><<<dim3(3072 / 64, (kr + 63) / 64), 256, 0, stream>>>(H + (size_t)k0 * D, D, w_qkv, 3072, b_qkv, QKV, 3072, kr, 3072, D);
                nk_na_attn<<<CH * 16 / 4, 256, 0, stream>>>(QKV, k0, c0, rpb, Oc);
                nk_gemm<0><<<dim3(D / 64, CH / 64), 256, 0, stream>>>(Oc, D, w_o, D, b_o, Yc, D, CH, D, D);
                nk_residual<<<CH / 4, 256, 0, stream>>>(xp, xs, out, 1, lg, lb, mods_l, 2, Yc, 0, c0, nullptr);
            }
        }
        const float* lg = ln_g + (layer * 2 + 0) * D; const float* lb = ln_b + (layer * 2 + 0) * D;
        nk_ln_mod<<<NTOK / 4, 256, 0, stream>>>(xp, xs, out, 1, lg, lb, mods_l, 3, 4, H);
        float* UG = R1; float* Ac = R1 + (size_t)96 * MB / 4; float* Yc = R1 + (size_t)144 * MB / 4;
        const float* wi = w_in + (size_t)layer * D * 2 * DFF; const float* bi = b_in + (size_t)layer * 2 * DFF;
        const float* cw = conv_w + (size_t)layer * 3 * DFF; const float* cb = conv_b + (size_t)layer * DFF;
        const float* wo = w_out + (size_t)layer * DFF * D; const float* bo = b_out + (size_t)layer * D;
        for (int c0 = 0; c0 < NTOK; c0 += CH) {
            const int b = tok_b(c0), s0 = seq_start(b), s1 = s0 + seq_len(b);
            int u0 = c0 - 1; if (u0 < s0) u0 = s0; int u1 = c0 + CH + 1; if (u1 > s1) u1 = s1;
            const int ur = u1 - u0;
            nk_gemm<0><<<dim3(2 * DFF / 64, (ur + 63) / 64), 256, 0, stream>>>(H + (size_t)u0 * D, D, wi, 2 * DFF, bi, UG, 2 * DFF, ur, 2 * DFF, D);
            nk_convgate<<<(CH * DFF + 255) / 256, 256, 0, stream>>>(UG, u0, c0, CH, cw, cb, Ac);
            nk_gemm<0><<<dim3(D / 64, CH / 64), 256, 0, stream>>>(Ac, DFF, wo, D, bo, Yc, D, CH, D, DFF);
            nk_residual<<<CH / 4, 256, 0, stream>>>(xp, xs, out, 1, lg, lb, mods_l, 5, Yc, 0, c0, nullptr);
        }
    }
    nk_final_ln<<<NTOK / 4, 256, 0, stream>>>(out, ln_g + 3 * D, ln_b + 3 * D);
}
```

```cpp
#define MK_NOPT 5
#define MK_ONE 0
#include <hip/hip_runtime.h>
#include <hip/hip_cooperative_groups.h>
#include <cstdio>
#include <math.h>
namespace cg = cooperative_groups;
#define LAS __attribute__((address_space(3)))
typedef unsigned short bf16_t;
typedef short bf16x8 __attribute__((ext_vector_type(8)));
typedef short s16x4 __attribute__((ext_vector_type(4)));
typedef float f32x4 __attribute__((ext_vector_type(4)));
typedef unsigned u32x4 __attribute__((ext_vector_type(4)));
typedef unsigned u32x2 __attribute__((ext_vector_type(2)));

constexpr int NTOK = 49152, D = 1024, NB = 9, DFF = 2816, NPROMPT = 16384, SSEQ = 4096;
constexpr float ALPHA = 1.41421356237309515f;
constexpr float LN_EPS = 1e-5f;
constexpr int NTHR = 512;

__device__ __host__ inline int tok_b(int t) { return t < NPROMPT ? 0 : 1 + ((t - NPROMPT) >> 12); }
__device__ __host__ inline int seq_start(int b) { return b == 0 ? 0 : NPROMPT + (b - 1) * SSEQ; }
__device__ __host__ inline int seq_len(int b) { return b == 0 ? NPROMPT : SSEQ; }

__device__ __forceinline__ unsigned cvt_pk_bf16(float lo, float hi) { unsigned r; asm volatile("v_cvt_pk_bf16_f32 %0, %1, %2" : "=v"(r) : "v"(lo), "v"(hi)); return r; }
__device__ __forceinline__ bf16_t f2bf(float f) { return (bf16_t)(cvt_pk_bf16(f, 0.f) & 0xffffu); }
__device__ __forceinline__ float sigmoid_f(float x) { return __builtin_amdgcn_rcpf(1.0f + __expf(-x)); }
__device__ __forceinline__ float gelu_f(float x) { const float u2 = 1.5957691216057308f * x * (1.0f + 0.044715f * x * x); return x * __builtin_amdgcn_rcpf(1.0f + __expf(-u2)); }
__device__ __forceinline__ u32x4 pack8(const f32x4& a, const f32x4& b) { u32x4 w; w.x = cvt_pk_bf16(a[0], a[1]); w.y = cvt_pk_bf16(a[2], a[3]); w.z = cvt_pk_bf16(b[0], b[1]); w.w = cvt_pk_bf16(b[2], b[3]); return w; }
__device__ __forceinline__ int lane_id_asm() { int l_; asm volatile("v_mbcnt_lo_u32_b32 %0, -1, 0\n\tv_mbcnt_hi_u32_b32 %0, -1, %0" : "=v"(l_)); return l_; }
__device__ __forceinline__ void atomic_add_f32(float* p, float v) { (void)__hip_atomic_fetch_add(p, v, __ATOMIC_RELAXED, __HIP_MEMORY_SCOPE_AGENT); }

constexpr int BK = 64, HTB = 128 * BK * 2  , STAGE_BYTES = 8 * HTB, NXCD = 8, WGM = 8;
__host__ __device__ __forceinline__ int lds_byte(int r, int c) { const int st = (r >> 4) * 2 + (c >> 5), rr = r & 15, cc = c & 31, ob = rr * 64 + cc * 2; return st * 1024 + (ob ^ (((ob >> 9) & 1) << 5)); }
__host__ __device__ __forceinline__ void stage_rc(int b, int& R, int& C) { const int st = b / 1024, sb = b % 1024, swz = sb ^ (((sb >> 9) & 1) << 5); R = (st >> 1) * 16 + swz / 64; C = (st & 1) * 32 + (swz % 64) / 2; }
__host__ __device__ __forceinline__ int perm32(int rho) { const int n = rho >> 4, i = rho & 15; return 8 * (i >> 2) + 4 * n + (i & 3); }
__host__ __device__ __forceinline__ int col_of(int np) { return (np & ~31) + perm32(np & 31); }

struct Unit { const char* a0; const char* a1; const char* b; int i0, i1; };
struct GShape { int nt; unsigned a_rs, a_gs, b_rs; };

struct TileOrder {
    int nM, nN, nwg, G, c;
    __device__ void init(int nM_, int nN_, int G_, int c_) { nM = nM_; nN = nN_; nwg = nM * nN; G = G_; c = c_; }
    __device__ bool get(int i, int& pm, int& pn) const {
        const long L = (long)i * G + c; if (L >= nwg) return false;
        int wgid = (int)L; { const int q = nwg / NXCD, r = nwg % NXCD, xcd = wgid % NXCD, off = wgid / NXCD; wgid = (xcd < r ? xcd * (q + 1) : r * (q + 1) + (xcd - r) * q) + off; }
        const int nig = WGM * nN, gid = wgid / nig, fm = gid * WGM, gsz = (nM - fm) < WGM ? (nM - fm) : WGM;
        pm = fm + ((wgid % nig) % gsz); pn = (wgid % nig) / gsz; return true;
    }
};

template <class Epi, class Sched>
__device__ __forceinline__ void gemm_phase(LAS unsigned char* lds, const GShape g, const Sched& S, const Epi& E, const int tid) {
    const int wid = __builtin_amdgcn_readfirstlane(tid >> 6), lane = tid & 63, wr = wid >> 2, wc = wid & 3, fr = lane & 15, fq = lane >> 4;
    const int nt = g.nt;
    unsigned voffA[2], voffB[2];
#pragma unroll
    for (int i = 0; i < 2; ++i) { int R, C; stage_rc(tid * 16 + i * 8192, R, C);
        voffA[i] = (unsigned)(R & 63) * g.a_rs + (unsigned)(C >> 4) * g.a_gs + (unsigned)(C & 15) * 2u; voffB[i] = (unsigned)R * g.b_rs + (unsigned)C * 2u; }
    const size_t kstepA = (size_t)g.a_gs * 4, kstepB = (size_t)(BK * 2);
    const size_t hstepA = (size_t)g.a_rs * 64, hstepB = (size_t)g.b_rs * 128;
    const unsigned ldsw = (unsigned)wid * 1024u;
    const int aoff = lds_byte(wr * 64 + fr, fq * 8), boff = lds_byte(wc * 32 + fr, fq * 8);
#define G_SA(b, h) (((b) * 2 + (h)) * HTB)
#define G_SB(b, h) ((4 + (b) * 2 + (h)) * HTB)
#define G_GLDS(src, dstoff) __builtin_amdgcn_global_load_lds((const unsigned*)(src), (LAS unsigned*)(lds + (dstoff)), 16, 0, 0)
#define G_STAGE_A(bufoff, p0, p1) do { G_GLDS((p0) + voffA[0], (bufoff) + ldsw); G_GLDS((p1) + voffA[1], (bufoff) + ldsw + 8192); } while (0)
#define G_STAGE_B(bufoff, pb) do { G_GLDS((pb) + voffB[0], (bufoff) + ldsw); G_GLDS((pb) + voffB[1], (bufoff) + ldsw + 8192); } while (0)
#define G_LDA(dst, b, h) do { _Pragma("unroll") for (int m = 0; m < 4; ++m) _Pragma("unroll") for (int k = 0; k < 2; ++k) dst[m][k] = *(const LAS bf16x8*)(lds + G_SA(b, h) + aoff + m * 2048 + k * 1024); } while (0)
#define G_LDB(dst, b, h) do { _Pragma("unroll") for (int n = 0; n < 2; ++n) _Pragma("unroll") for (int k = 0; k < 2; ++k) dst[n][k] = *(const LAS bf16x8*)(lds + G_SB(b, h) + boff + n * 2048 + k * 1024); } while (0)
#define G_MMA(ai, bj, At, Bt) do { __builtin_amdgcn_s_setprio(1); _Pragma("unroll") for (int m = 0; m < 4; ++m) _Pragma("unroll") for (int n = 0; n < 2; ++n) _Pragma("unroll") for (int k = 0; k < 2; ++k) \
        acc[ai][bj][m][n] = __builtin_amdgcn_mfma_f32_16x16x32_bf16(Bt[n][k], At[m][k], acc[ai][bj][m][n], 0, 0, 0); __builtin_amdgcn_s_setprio(0); } while (0)
#define G_WAIT_V(n) asm volatile("s_waitcnt vmcnt(" #n ")" ::: "memory")
#define G_WAIT_L(n) asm volatile("s_waitcnt lgkmcnt(" #n ")" ::: "memory")
#define G_BAR __builtin_amdgcn_s_barrier()
#define G_SCHED __builtin_amdgcn_sched_barrier(0)
    Unit cur, nxt; int ui = 0;
    if (!S.next(0, cur)) return;
    f32x4 acc[2][2][4][2];
#pragma unroll
    for (int a = 0; a < 2; ++a)
#pragma unroll
        for (int b = 0; b < 2; ++b)
#pragma unroll
            for (int m = 0; m < 4; ++m)
#pragma unroll
                for (int n = 0; n < 2; ++n) acc[a][b][m][n] = (f32x4){0.f, 0.f, 0.f, 0.f};
    bf16x8 At[4][2], B0[2][2], B1[2][2];
    const char* cA0 = cur.a0; const char* cA1 = cur.a1; const char* cB = cur.b;
    G_STAGE_B(G_SB(0, 0), cB); G_STAGE_B(G_SB(0, 1), cB + hstepB); G_STAGE_A(G_SA(0, 0), cA0, cA1); G_STAGE_A(G_SA(0, 1), cA0 + hstepA, cA1 + hstepA);
    if (wr == 1) G_BAR;
    G_WAIT_V(2); G_BAR;
    G_STAGE_B(G_SB(1, 0), cB + kstepB); G_STAGE_A(G_SA(1, 0), cA0 + kstepA, cA1 + kstepA); G_STAGE_B(G_SB(1, 1), cB + hstepB + kstepB);
    G_WAIT_V(6); G_BAR;
    for (;;) {
        const bool has_next = S.next(ui + 1, nxt);
        const char* nA0 = has_next ? nxt.a0 : cA0; const char* nA1 = has_next ? nxt.a1 : cA1; const char* nB = has_next ? nxt.b : cB;
        for (int t = 0; t < nt; t += 2) {
            const bool last = (t == nt - 2);
            const char* a1_0 = cA0 + (size_t)(t + 1) * kstepA; const char* a1_1 = cA1 + (size_t)(t + 1) * kstepA;
            const char* a2_0 = last ? nA0 : cA0 + (size_t)(t + 2) * kstepA; const char* a2_1 = last ? nA1 : cA1 + (size_t)(t + 2) * kstepA;
            const char* b2 = last ? nB : cB + (size_t)(t + 2) * kstepB;
            const char* a3_0 = a2_0 + kstepA; const char* a3_1 = a2_1 + kstepA; const char* b3 = b2 + kstepB;
            G_LDB(B0, 0, 0); G_LDB(B1, 0, 1); G_SCHED; G_LDA(At, 0, 0); G_STAGE_A(G_SA(1, 1), a1_0 + hstepA, a1_1 + hstepA);
            G_WAIT_V(8); G_WAIT_L(0); G_BAR; G_MMA(0, 0, At, B0); G_MMA(0, 1, At, B1); G_BAR; G_SCHED;
            G_LDA(At, 0, 1); G_STAGE_B(G_SB(0, 0), b2); G_STAGE_B(G_SB(0, 1), b2 + hstepB); G_STAGE_A(G_SA(0, 0), a2_0, a2_1);
            G_WAIT_V(8); G_WAIT_L(0); G_BAR; G_MMA(1, 0, At, B0); G_MMA(1, 1, At, B1); G_BAR; G_SCHED;
            G_LDB(B0, 1, 0); G_LDB(B1, 1, 1); G_SCHED; G_LDA(At, 1, 0); G_STAGE_A(G_SA(0, 1), a2_0 + hstepA, a2_1 + hstepA);
            G_WAIT_V(8); G_WAIT_L(0); G_BAR; G_MMA(0, 0, At, B0); G_MMA(0, 1, At, B1); G_BAR; G_SCHED;
            G_LDA(At, 1, 1); G_STAGE_B(G_SB(1, 0), b3); G_STAGE_B(G_SB(1, 1), b3 + hstepB); G_STAGE_A(G_SA(1, 0), a3_0, a3_1);
            G_WAIT_V(8); G_WAIT_L(0); G_BAR; G_MMA(1, 0, At, B0); G_MMA(1, 1, At, B1); G_BAR; G_SCHED;
        }
        if (wr == 0) G_BAR;
        { int l_; asm volatile("v_mbcnt_lo_u32_b32 %0, -1, 0\n\tv_mbcnt_hi_u32_b32 %0, -1, %0" : "=v"(l_));
          E(acc, cur, wr, wc, l_ & 15, l_ >> 4); }
        if (!has_next) break;
#pragma unroll
        for (int a = 0; a < 2; ++a)
#pragma unroll
            for (int b = 0; b < 2; ++b)
#pragma unroll
                for (int m = 0; m < 4; ++m)
#pragma unroll
                    for (int n = 0; n < 2; ++n) acc[a][b][m][n] = (f32x4){0.f, 0.f, 0.f, 0.f};
        cur = nxt; cA0 = nA0; cA1 = nA1; cB = nB; ++ui;
        if (wr == 1) G_BAR;
    }
    G_WAIT_V(0);
    G_BAR;
#undef G_SA
#undef G_SB
#undef G_GLDS
#undef G_STAGE_A
#undef G_STAGE_B
#undef G_LDA
#undef G_LDB
#undef G_MMA
#undef G_WAIT_V
#undef G_WAIT_L
#undef G_BAR
#undef G_SCHED
}
namespace nk {
__device__ inline float gelu_tanh(float x) { const float u = 0.7978845608028654f * (x + 0.044715f * x * x * x); return 0.5f * x * (1.0f + tanhf(u)); }
__device__ inline float wave_sum(float v) { for (int o = 32; o >= 1; o >>= 1) v += __shfl_xor(v, o); return v; }

__global__ void nk_mods(const float* cp, const float* cs, const float* w_ada, const float* b_ada, float* mods) {
    __shared__ float cond[NB][D];
    for (int i = threadIdx.x; i < NB * D; i += 256) { const int b = i / D, k = i % D; const float c = b == 0 ? cp[k] : cs[(b - 1) * D + k]; cond[b][k] = c / (1.0f + expf(-c)); }
    __syncthreads();
    const int col = blockIdx.x * 256 + threadIdx.x, layer = col / 6144, n = col % 6144;
    float acc[NB];
    for (int b = 0; b < NB; ++b) acc[b] = 0.f;
    const float* w = w_ada + (size_t)layer * D * 6144 + n;
    for (int k = 0; k < D; ++k) { const float wv = w[(size_t)k * 6144]; for (int b = 0; b < NB; ++b) acc[b] += cond[b][k] * wv; }
    for (int b = 0; b < NB; ++b) mods[(size_t)(layer * NB + b) * 6144 + n] = acc[b] + b_ada[layer * 6144 + n];
}

__global__ void nk_ln_mod(const float* xp, const float* xs, const float* v, int use_ln, const float* lng, const float* lnb, const float* mods_l, int sh_off, int sc_off, float* H) {
    const int row = blockIdx.x * 4 + (threadIdx.x >> 6), lane = threadIdx.x & 63, b = tok_b(row);
    const float* src = use_ln ? v + (size_t)row * D : (row < NPROMPT ? xp + (size_t)row * D : xs + (size_t)(row - NPROMPT) * D);
    float4 x[4];
    for (int j = 0; j < 4; ++j) x[j] = *(const float4*)(src + j * 256 + lane * 4);
    if (use_ln) {
        float s = 0.f; for (int j = 0; j < 4; ++j) s += x[j].x + x[j].y + x[j].z + x[j].w;
        const float mean = wave_sum(s) * (1.0f / D);
        float q = 0.f; for (int j = 0; j < 4; ++j) { float d0 = x[j].x - mean, d1 = x[j].y - mean, d2 = x[j].z - mean, d3 = x[j].w - mean; q += d0 * d0 + d1 * d1 + d2 * d2 + d3 * d3; }
        const float rstd = rsqrtf(wave_sum(q) * (1.0f / D) + LN_EPS);
        for (int j = 0; j < 4; ++j) { const int n = j * 256 + lane * 4; const float4 g = *(const float4*)(lng + n), bb = *(const float4*)(lnb + n);
            x[j].x = (x[j].x - mean) * rstd * g.x + bb.x; x[j].y = (x[j].y - mean) * rstd * g.y + bb.y; x[j].z = (x[j].z - mean) * rstd * g.z + bb.z; x[j].w = (x[j].w - mean) * rstd * g.w + bb.w; }
    }
    const float* m = mods_l + (size_t)b * 6144;
    for (int j = 0; j < 4; ++j) { const int n = j * 256 + lane * 4; const float4 sc = *(const float4*)(m + sc_off * D + n), sh = *(const float4*)(m + sh_off * D + n);
        float4 o; o.x = x[j].x * (1.f + sc.x) + sh.x; o.y = x[j].y * (1.f + sc.y) + sh.y; o.z = x[j].z * (1.f + sc.z) + sh.z; o.w = x[j].w * (1.f + sc.w) + sh.w;
        *(float4*)(H + (size_t)row * D + n) = o; }
}

template <int ACT> __global__ void nk_gemm(const float* A, int lda, const float* W, int ldw, const float* bias, float* C, int ldc, int M, int N, int K) {
    __shared__ float As[16][68], Ws[16][64];
    const int tid = threadIdx.x, tx = tid & 15, ty = tid >> 4, m0 = blockIdx.y * 64, n0 = blockIdx.x * 64;
    float acc[4][4];
    for (int i = 0; i < 4; ++i) for (int j = 0; j < 4; ++j) acc[i][j] = 0.f;
    const int ar = tid >> 2, ak = (tid & 3) * 4; int arow = m0 + ar; if (arow >= M) arow = M - 1;
    const int wr = tid >> 4, wc = (tid & 15) * 4;
    for (int k0 = 0; k0 < K; k0 += 16) {
        float4 a = *(const float4*)(A + (size_t)arow * lda + k0 + ak);
        if (ACT == 1) { a.x = gelu_tanh(a.x); a.y = gelu_tanh(a.y); a.z = gelu_tanh(a.z); a.w = gelu_tanh(a.w); }
        const float4 w = *(const float4*)(W + (size_t)(k0 + wr) * ldw + n0 + wc);
        As[ak + 0][ar] = a.x; As[ak + 1][ar] = a.y; As[ak + 2][ar] = a.z; As[ak + 3][ar] = a.w;
        *(float4*)&Ws[wr][wc] = w;
        __syncthreads();
#pragma unroll
        for (int kk = 0; kk < 16; ++kk) { const float4 av = *(const float4*)&As[kk][ty * 4]; const float4 wv = *(const float4*)&Ws[kk][tx * 4];
            const float aa[4] = {av.x, av.y, av.z, av.w}, ww[4] = {wv.x, wv.y, wv.z, wv.w};
#pragma unroll
            for (int i = 0; i < 4; ++i)
#pragma unroll
                for (int j = 0; j < 4; ++j) acc[i][j] += aa[i] * ww[j]; }
        __syncthreads();
    }
    for (int i = 0; i < 4; ++i) { const int r = m0 + ty * 4 + i; if (r >= M) continue;
        float4 o; const int c = n0 + tx * 4; o.x = acc[i][0] + bias[c]; o.y = acc[i][1] + bias[c + 1]; o.z = acc[i][2] + bias[c + 2]; o.w = acc[i][3] + bias[c + 3];
        *(float4*)(C + (size_t)r * ldc + c) = o; }
}

__global__ void nk_dskip(const float* H, const float* d, float* Y) { const size_t i = (size_t)blockIdx.x * 256 + threadIdx.x; Y[i] = H[i] * d[i & (D - 1)]; }

__global__ void nk_s5_scan(const float* H, float* Y, int dir, const float* lam_re, const float* lam_im, const float* log_dt, const float* b_re, const float* b_im, const float* c_re, const float* c_im) {
    const int b = blockIdx.x / 64, g = blockIdx.x % 64, p = threadIdx.x;
    const int idx = (dir * 64 + g) * 64 + p;
    const double dt = exp((double)log_dt[dir * 64 + g]), lr = lam_re[idx], li = lam_im[idx];
    const double zr = lr * dt, zi = li * dt, mag = exp(zr), abr_d = mag * cos(zi), abi_d = mag * sin(zi);
    const double den = lr * lr + li * li, nr = abr_d - 1.0, ni = abi_d, fr = (nr * lr + ni * li) / den, fi = (ni * lr - nr * li) / den;
    float bbr[16], bbi[16], cr[16], ci[16];
    for (int h = 0; h < 16; ++h) { const double br = b_re[(size_t)idx * 16 + h], bi = b_im[(size_t)idx * 16 + h]; bbr[h] = (float)(fr * br - fi * bi); bbi[h] = (float)(fr * bi + fi * br);
        cr[h] = c_re[((size_t)(dir * 64 + g) * 16 + h) * 64 + p]; ci[h] = c_im[((size_t)(dir * 64 + g) * 16 + h) * 64 + p]; }
    const float abr = (float)abr_d, abi = (float)abi_d;
    const int s0 = seq_start(b), S = seq_len(b);
    float sr = 0.f, si = 0.f;
    for (int i = 0; i < S; ++i) {
        const int t = s0 + (dir == 0 ? i : S - 1 - i);
        const float* u = H + (size_t)t * D + g * 16;
        float bur = 0.f, bui = 0.f;
#pragma unroll
        for (int h = 0; h < 16; ++h) { const float uv = u[h]; bur += uv * bbr[h]; bui += uv * bbi[h]; }
        const float nsr = abr * sr - abi * si + bur, nsi = abr * si + abi * sr + bui; sr = nsr; si = nsi;
        float mine = 0.f;
#pragma unroll
        for (int h = 0; h < 16; ++h) { const float r = wave_sum(cr[h] * sr - ci[h] * si); if (p == h) mine = r; }
        if (p < 16) Y[(size_t)t * D + g * 16 + p] += mine;
    }
}

__global__ void nk_residual(const float* xp, const float* xs, float* vio, int use_ln, const float* lng, const float* lnb, const float* mods_l, int gate_off, const float* Ysrc, int glu, int row0, float* stats) {
    const int rc = blockIdx.x * 4 + (threadIdx.x >> 6), row = row0 + rc, lane = threadIdx.x & 63, b = tok_b(row);
    const float* src = use_ln ? vio + (size_t)row * D : (row < NPROMPT ? xp + (size_t)row * D : xs + (size_t)(row - NPROMPT) * D);
    float4 x[4];
    for (int j = 0; j < 4; ++j) x[j] = *(const float4*)(src + j * 256 + lane * 4);
    if (use_ln) {
        float s = 0.f; for (int j = 0; j < 4; ++j) s += x[j].x + x[j].y + x[j].z + x[j].w;
        const float mean = wave_sum(s) * (1.0f / D);
        float q = 0.f; for (int j = 0; j < 4; ++j) { float d0 = x[j].x - mean, d1 = x[j].y - mean, d2 = x[j].z - mean, d3 = x[j].w - mean; q += d0 * d0 + d1 * d1 + d2 * d2 + d3 * d3; }
        const float rstd = rsqrtf(wave_sum(q) * (1.0f / D) + LN_EPS);
        for (int j = 0; j < 4; ++j) { const int n = j * 256 + lane * 4; const float4 g = *(const float4*)(lng + n), bb = *(const float4*)(lnb + n);
            x[j].x = (x[j].x - mean) * rstd * g.x + bb.x; x[j].y = (x[j].y - mean) * rstd * g.y + bb.y; x[j].z = (x[j].z - mean) * rstd * g.z + bb.z; x[j].w = (x[j].w - mean) * rstd * g.w + bb.w; }
    }
    const float* gate = mods_l + (size_t)b * 6144 + gate_off * D;
    float s1 = 0.f, s2 = 0.f;
    for (int j = 0; j < 4; ++j) { const int n = j * 256 + lane * 4; float4 y;
        if (glu) { const float4 a = *(const float4*)(Ysrc + (size_t)rc * 2048 + n), g = *(const float4*)(Ysrc + (size_t)rc * 2048 + 1024 + n);
            y.x = a.x / (1.f + expf(-g.x)); y.y = a.y / (1.f + expf(-g.y)); y.z = a.z / (1.f + expf(-g.z)); y.w = a.w / (1.f + expf(-g.w)); }
        else y = *(const float4*)(Ysrc + (size_t)rc * D + n);
        const float4 gt = *(const float4*)(gate + n);
        float4 o; o.x = ALPHA * x[j].x + gt.x * y.x; o.y = ALPHA * x[j].y + gt.y * y.y; o.z = ALPHA * x[j].z + gt.z * y.z; o.w = ALPHA * x[j].w + gt.w * y.w;
        s1 += o.x + o.y + o.z + o.w; s2 += o.x * o.x + o.y * o.y + o.z * o.z + o.w * o.w;
        *(float4*)(vio + (size_t)row * D + n) = o; }
    s1 = wave_sum(s1); s2 = wave_sum(s2);
    if (lane == 0 && stats) { stats[row * 2] = s1; stats[row * 2 + 1] = s2; }
}

__global__ void nk_convgate(const float* UG, int ug0, int t0, int rows, const float* cw, const float* cb, float* Ac) {
    const size_t i = (size_t)blockIdx.x * 256 + threadIdx.x; if (i >= (size_t)rows * DFF) return;
    const int r = (int)(i / DFF), ch = (int)(i % DFF), t = t0 + r, b = tok_b(t), s0 = seq_start(b), s1 = s0 + seq_len(b);
    const float* u = UG + (size_t)(t - ug0) * (2 * DFF) + ch;
    const float up = (t - 1 >= s0) ? u[-(2 * DFF)] : 0.f, uc = u[0], un = (t + 1 < s1) ? u[2 * DFF] : 0.f;
    const float c = up * cw[ch] + uc * cw[DFF + ch] + un * cw[2 * DFF + ch] + cb[ch];
    Ac[(size_t)r * DFF + ch] = gelu_tanh(c) * u[DFF];
}

__global__ void nk_na_attn(const float* QKV, int kv0, int t0, const float* rpb, float* Oc) {
    const int wid = blockIdx.x * 4 + (threadIdx.x >> 6), lane = threadIdx.x & 63;
    const int r = wid >> 4, h = wid & 15, t = t0 + r, b = tok_b(t), s0 = seq_start(b), nrows = seq_len(b) / 64;
    const int tl = t - s0, gr = tl >> 6, gc = tl & 63;
    int rs = gr - 4; rs = rs < 0 ? 0 : (rs > nrows - 8 ? nrows - 8 : rs);
    int cs = gc - 8; cs = cs < 0 ? 0 : (cs > 48 ? 48 : cs);
    __shared__ float qs[4][64]; __shared__ float ps[4][128];
    const int w = threadIdx.x >> 6;
    qs[w][lane] = QKV[(size_t)(t - kv0) * 3072 + h * 64 + lane] * 0.125f;
    __syncthreads();
    float sc[2];
    for (int j = 0; j < 2; ++j) { const int kk = lane + j * 64, kr = rs + (kk >> 4), kc = cs + (kk & 15), kt = s0 + kr * 64 + kc;
        const float* kp = QKV + (size_t)(kt - kv0) * 3072 + 1024 + h * 64; float s = 0.f;
        for (int d = 0; d < 64; d += 4) { const float4 kv = *(const float4*)(kp + d); s += qs[w][d] * kv.x + qs[w][d + 1] * kv.y + qs[w][d + 2] * kv.z + qs[w][d + 3] * kv.w; }
        sc[j] = s + rpb[(h * 15 + (kr - gr + 7)) * 31 + (kc - gc + 15)]; }
    float m = fmaxf(sc[0], sc[1]); for (int o = 32; o >= 1; o >>= 1) m = fmaxf(m, __shfl_xor(m, o));
    const float e0 = expf(sc[0] - m), e1 = expf(sc[1] - m); const float sum = wave_sum(e0 + e1);
    ps[w][lane] = e0 / sum; ps[w][lane + 64] = e1 / sum;
    __syncthreads();
    float o = 0.f;
    for (int kk = 0; kk < 128; ++kk) { const int kr = rs + (kk >> 4), kc = cs + (kk & 15), kt = s0 + kr * 64 + kc; o += ps[w][kk] * QKV[(size_t)(kt - kv0) * 3072 + 2048 + h * 64 + lane]; }
    Oc[(size_t)r * D + h * 64 + lane] = o;
}

__global__ void nk_final_ln(float* v, const float* lng, const float* lnb) {
    const int row = blockIdx.x * 4 + (threadIdx.x >> 6), lane = threadIdx.x & 63;
    float4 x[4];
    for (int j = 0; j < 4; ++j) x[j] = *(const float4*)(v + (size_t)row * D + j * 256 + lane * 4);
    float s = 0.f; for (int j = 0; j < 4; ++j) s += x[j].x + x[j].y + x[j].z + x[j].w;
    const float mean = wave_sum(s) * (1.0f / D);
    float q = 0.f; for (int j = 0; j < 4; ++j) { float d0 = x[j].x - mean, d1 = x[j].y - mean, d2 = x[j].z - mean, d3 = x[j].w - mean; q += d0 * d0 + d1 * d1 + d2 * d2 + d3 * d3; }
    const float rstd = rsqrtf(wave_sum(q) * (1.0f / D) + LN_EPS);
    for (int j = 0; j < 4; ++j) { const int n = j * 256 + lane * 4; const float4 g = *(const float4*)(lng + n), bb = *(const float4*)(lnb + n);
        float4 o; o.x = (x[j].x - mean) * rstd * g.x + bb.x; o.y = (x[j].y - mean) * rstd * g.y + bb.y; o.z = (x[j].z - mean) * rstd * g.z + bb.z; o.w = (x[j].w - mean) * rstd * g.w + bb.w;
        *(float4*)(v + (size_t)row * D + n) = o; }
}

}
constexpr size_t KiB = 1024, MiB = 1024 * 1024;
constexpr size_t WS_CTL = 0;
constexpr size_t WS_MODS = 64 * KiB;
constexpr size_t WS_CVEC = 512 * KiB;
constexpr size_t WS_GAM = 1536 * KiB;
constexpr size_t WS_STATS = 2 * MiB;
constexpr size_t WS_PW = 4 * MiB;
constexpr size_t WS_BBAR = 9 * MiB;
constexpr size_t WS_KTAB = 10 * MiB;
constexpr size_t WS_WGLU = 18 * MiB;
constexpr size_t WS_WIN = 22 * MiB;
constexpr size_t WS_WOUT = 44 * MiB;
constexpr size_t WS_WQKV = 55 * MiB;
constexpr size_t WS_WO = 61 * MiB;
constexpr size_t WS_S = 64 * MiB;
constexpr size_t WS_YG = WS_S;
constexpr size_t WS_BSEND = WS_S;
constexpr size_t WS_SEND = WS_S + 32 * MiB;
constexpr size_t WS_AS5 = WS_S + 96 * MiB;
constexpr size_t WS_BS5 = WS_S + 216 * MiB;
constexpr size_t WS_APR = WS_S + 288 * MiB + 4096;
constexpr size_t WS_A0 = WS_S;
constexpr size_t WS_QKV = WS_S;
constexpr size_t WS_O = WS_S + 288 * MiB;
constexpr size_t WS_APR3 = WS_S + 4096;
constexpr size_t WS_A1 = WS_S + 100 * MiB;
constexpr size_t WS_NEED = WS_S + 386 * MiB;
constexpr int CV_IN0 = 0, CV_QKV = 2 * 9 * 5632, CV_IN1 = CV_QKV + 2 * 9 * 3072;

struct Params { const float* in[29]; float* out; unsigned char* ws; };
enum { I_XP = 0, I_XS, I_CP, I_CS, I_WADA, I_BADA, I_LNG, I_LNB, I_LRE, I_LIM, I_LDT, I_BRE, I_BIM, I_CRE, I_CIM, I_SD, I_WGLU, I_BGLU, I_WQKV, I_BQKV, I_RPB, I_WO, I_BO, I_WIN, I_BIN, I_CW, I_CB, I_WOUT, I_BOUT };

__device__ __forceinline__ const float* xin_row(const Params& p, int t) { return t < NPROMPT ? p.in[I_XP] + (size_t)t * D : p.in[I_XS] + (size_t)(t - NPROMPT) * D; }
__device__ __forceinline__ void row_stats(const float* st, int tok, float& mean, float& rstd) {
    const float2 s = *(const float2*)(st + (size_t)tok * 2); mean = s.x * (1.0f / D); const float var = s.y * (1.0f / D) - mean * mean; rstd = rsqrtf(fmaxf(var, 0.f) + LN_EPS); }

struct SchedPlain {
    TileOrder o; const char* A; const char* B; size_t a_rs, b_rs;
    __device__ bool next(int i, Unit& u) const { int pm, pn; if (!o.get(i, pm, pn)) return false;
        u.a0 = A + (size_t)(pm * 256) * a_rs; u.a1 = u.a0 + 128 * a_rs; u.b = B + (size_t)pn * 256 * b_rs; u.i0 = pm * 256; u.i1 = pn; return true; }
};
struct SchedS5 {
    TileOrder o; const char* A; const char* B; size_t b_gstride  , b_rs;
    __device__ bool next(int i, Unit& u) const { int pm, pn; if (!o.get(i, pm, pn)) return false; const int g = pm / 3;
        u.a0 = A + (size_t)(pm * 256) * 2560; u.a1 = u.a0 + (size_t)128 * 2560; u.b = B + (size_t)g * b_gstride + (size_t)pn * 256 * b_rs; u.i0 = pm * 256; u.i1 = pn; return true; }
};
__device__ __forceinline__ void ht_params(int ht, int& T, int& olo, int& ohi, int& s0, int& s1) {
    int b, jl;
    if (ht < 131) { b = 0; jl = ht; } else if (ht < 395) { b = 1 + (ht - 131) / 33; jl = (ht - 131) % 33; } else { T = 0; olo = 0; ohi = 0; s0 = 0; s1 = NPROMPT; return; }
    s0 = seq_start(b); s1 = s0 + seq_len(b); olo = s0 + 126 * jl; ohi = olo + 126 < s1 ? olo + 126 : s1; T = olo - 1;
}
constexpr int FFN_UNITS_M = 198;
struct SchedFfnIn {
    TileOrder o; const char* A; const char* B;
    __device__ bool next(int i, Unit& u) const { int pm, pn; if (!o.get(i, pm, pn)) return false; int T0, T1, a, b, c, d;
        ht_params(2 * pm, T0, a, b, c, d); ht_params(2 * pm + 1, T1, a, b, c, d);
        u.a0 = A + (long)T0 * 2048; u.a1 = A + (long)T1 * 2048; u.b = B + (size_t)pn * 256 * 2048; u.i0 = pm; u.i1 = pn; return true; }
};

typedef const f32x4 (&AccRef)[2][2][4][2];

struct EpiSend {
    float* C;
    __device__ __forceinline__ void operator()(AccRef acc, const Unit& u, int wr, int wc, int fr, int fq) const {
#pragma unroll
        for (int ai = 0; ai < 2; ++ai)
#pragma unroll
            for (int m = 0; m < 4; ++m) { float* p = C + (size_t)(u.i0 + 128 * wr + 64 * ai + 16 * m + fr) * 256 + 32 * wc + 8 * fq;
#pragma unroll
                for (int bj = 0; bj < 2; ++bj) { *(f32x4*)(p + 128 * bj) = acc[ai][bj][m][0]; *(f32x4*)(p + 128 * bj + 4) = acc[ai][bj][m][1]; } }
    }
};
struct EpiS5 {
    bf16_t* Y;
    __device__ __forceinline__ void operator()(AccRef acc, const Unit& u, int wr, int wc, int fr, int fq) const {
#pragma unroll
        for (int ai = 0; ai < 2; ++ai)
#pragma unroll
            for (int m = 0; m < 4; ++m) { bf16_t* p = Y + (size_t)(u.i0 + 128 * wr + 64 * ai + 16 * m + fr) * 1024 + u.i1 * 256 + 32 * wc + 8 * fq;
#pragma unroll
                for (int bj = 0; bj < 2; ++bj) { f32x4 v0 = acc[ai][bj][m][0], v1 = acc[ai][bj][m][1];
#pragma unroll
                    for (int j = 0; j < 4; ++j) { v0[j] = gelu_f(v0[j]); v1[j] = gelu_f(v1[j]); }
                    *(u32x4*)(p + 128 * bj) = pack8(v0, v1); }
                __builtin_amdgcn_sched_barrier(0); }
    }
};
struct EpiGlu {
    const float* xp; const float* xs; float* out; const float* bglu; const float* mods0; const float* gam; float* stats; bf16_t* apr;
    __device__ __forceinline__ void operator()(AccRef acc, const Unit& u, int wr, int wc, int fr, int fq) const {
        const int b = tok_b(u.i0), oc0 = 128 * u.i1 + 32 * wc + 8 * fq;
        f32x4 ba[2], bg[2], gm[2], ga[2];
#pragma unroll
        for (int n = 0; n < 2; ++n) { ba[n] = *(const f32x4*)(bglu + oc0 + 4 * n); bg[n] = *(const f32x4*)(bglu + 1024 + oc0 + 4 * n);
            gm[n] = *(const f32x4*)(mods0 + (size_t)b * 6144 + 2 * D + oc0 + 4 * n); ga[n] = *(const f32x4*)(gam + (size_t)b * D + oc0 + 4 * n); }
#pragma unroll
        for (int ai = 0; ai < 2; ++ai)
#pragma unroll
            for (int m = 0; m < 4; ++m) { const int tok = u.i0 + 128 * wr + 64 * ai + 16 * m + fr; const float* xr = (tok < NPROMPT ? xp + (size_t)tok * D : xs + (size_t)(tok - NPROMPT) * D) + oc0; float* vo = out + (size_t)tok * D + oc0;
                f32x4 v[2]; float s1 = 0.f, s2 = 0.f;
#pragma unroll
                for (int n = 0; n < 2; ++n) { const f32x4 x0 = *(const f32x4*)(xr + 4 * n); const f32x4 a = acc[ai][0][m][n] + ba[n], g = acc[ai][1][m][n] + bg[n];
#pragma unroll
                    for (int j = 0; j < 4; ++j) { const float gl = a[j] * sigmoid_f(g[j]); const float vv = ALPHA * x0[j] + gm[n][j] * gl; v[n][j] = vv; s1 += vv; s2 += vv * vv; }
                    *(f32x4*)(vo + 4 * n) = v[n]; }
                *(u32x4*)(apr + (size_t)tok * D + oc0) = pack8(v[0] * ga[0], v[1] * ga[1]);
                s1 += __shfl_xor(s1, 16); s2 += __shfl_xor(s2, 16); s1 += __shfl_xor(s1, 32); s2 += __shfl_xor(s2, 32);
                if (fq == 0) { atomic_add_f32(stats + (size_t)tok * 2, s1); atomic_add_f32(stats + (size_t)tok * 2 + 1, s2); } }
    }
};
struct EpiOut {
    float* vio; const float* bias; const float* lng; const float* lnb; const float* gate  ; const float* gam  ;
    const float* st_prev; float* st_next; bf16_t* apr;
    __device__ __forceinline__ void operator()(AccRef acc, const Unit& u, int wr, int wc, int fr, int fq) const {
        const int b = tok_b(u.i0);
        float s1[2][4], s2[2][4];
#pragma unroll
        for (int ai = 0; ai < 2; ++ai)
#pragma unroll
            for (int m = 0; m < 4; ++m) { s1[ai][m] = 0.f; s2[ai][m] = 0.f; }
#pragma unroll
        for (int bj = 0; bj < 2; ++bj) { const int oc0 = 256 * u.i1 + 128 * bj + 32 * wc + 8 * fq;
            f32x4 cp[2], cq[2], gt[2], ga[2];
#pragma unroll
            for (int n = 0; n < 2; ++n) { const f32x4 bi = *(const f32x4*)(bias + oc0 + 4 * n), lg = *(const f32x4*)(lng + oc0 + 4 * n), lb = *(const f32x4*)(lnb + oc0 + 4 * n);
                gt[n] = *(const f32x4*)(gate + (size_t)b * 6144 + oc0 + 4 * n); ga[n] = gam ? *(const f32x4*)(gam + (size_t)b * D + oc0 + 4 * n) : (f32x4){0.f, 0.f, 0.f, 0.f};
                cp[n] = lg * ALPHA; cq[n] = lb * ALPHA + gt[n] * bi; }
#pragma unroll
            for (int ai = 0; ai < 2; ++ai)
#pragma unroll
                for (int m = 0; m < 4; ++m) { const int tok = u.i0 + 128 * wr + 64 * ai + 16 * m + fr; float mean, rstd; row_stats(st_prev, tok, mean, rstd);
                    float* vp = (float*)((char*)vio + ((unsigned)tok * (unsigned)(D * 4) + (unsigned)oc0 * 4u)); f32x4 v[2];
#pragma unroll
                    for (int n = 0; n < 2; ++n) { const f32x4 vo = *(const f32x4*)(vp + 4 * n);
#pragma unroll
                        for (int j = 0; j < 4; ++j) { const float vv = rstd * cp[n][j] * (vo[j] - mean) + cq[n][j] + gt[n][j] * acc[ai][bj][m][n][j];
                            v[n][j] = vv; s1[ai][m] += vv; s2[ai][m] += vv * vv; }
                        *(f32x4*)(vp + 4 * n) = v[n]; }
                    if (apr) *(u32x4*)((char*)apr + ((unsigned)tok * (unsigned)(D * 2) + (unsigned)oc0 * 2u)) = pack8(v[0] * ga[0], v[1] * ga[1]); __builtin_amdgcn_sched_barrier(0); } }
#pragma unroll
        for (int ai = 0; ai < 2; ++ai)
#pragma unroll
            for (int m = 0; m < 4; ++m) { int fr2 = fr; asm volatile("" : "+v"(fr2)); const unsigned tok = (unsigned)(u.i0 + 128 * wr + 64 * ai + 16 * m + fr2); float a = s1[ai][m], q = s2[ai][m];
                a += __shfl_xor(a, 16); q += __shfl_xor(q, 16); a += __shfl_xor(a, 32); q += __shfl_xor(q, 32);
                if (st_next && fq == 0) { float* sp = (float*)((char*)st_next + tok * 8u); atomic_add_f32(sp, a); atomic_add_f32(sp + 1, q); } }
    }
};
struct EpiQkv {
    const float* c1; const float* c2; const float* st; bf16_t* O;
    __device__ __forceinline__ void operator()(AccRef acc, const Unit& u, int wr, int wc, int fr, int fq) const {
        const int b = tok_b(u.i0);
#pragma unroll
        for (int bj = 0; bj < 2; ++bj) { const int oc0 = 256 * u.i1 + 128 * bj + 32 * wc + 8 * fq; const float sc = oc0 < 1024 ? 0.125f : 1.0f;
            f32x4 k1[2], k2[2];
#pragma unroll
            for (int n = 0; n < 2; ++n) { k1[n] = *(const f32x4*)(c1 + (size_t)b * 3072 + oc0 + 4 * n); k2[n] = *(const f32x4*)(c2 + (size_t)b * 3072 + oc0 + 4 * n); }
#pragma unroll
            for (int ai = 0; ai < 2; ++ai)
#pragma unroll
                for (int m = 0; m < 4; ++m) { const int tok = u.i0 + 128 * wr + 64 * ai + 16 * m + fr; float mean, rstd; row_stats(st, tok, mean, rstd);
                    f32x4 v[2];
#pragma unroll
                    for (int n = 0; n < 2; ++n)
#pragma unroll
                        for (int j = 0; j < 4; ++j) v[n][j] = (rstd * (acc[ai][bj][m][n][j] - mean * k1[n][j]) + k2[n][j]) * sc;
                    *(u32x4*)(O + (size_t)tok * 3072 + oc0) = pack8(v[0], v[1]); __builtin_amdgcn_sched_barrier(0); } }
    }
};
__device__ __forceinline__ float dpp_prev(float cur, float prevgrp) {
    const int rot = __builtin_amdgcn_update_dpp(0, __float_as_int(prevgrp), 0x121  , 0xf, 0xf, false);
    return __int_as_float(__builtin_amdgcn_update_dpp(rot, __float_as_int(cur), 0x111  , 0xf, 0xf, false)); }
__device__ __forceinline__ float dpp_next(float cur, float nextgrp) {
    const int rot = __builtin_amdgcn_update_dpp(0, __float_as_int(nextgrp), 0x12F  , 0xf, 0xf, false);
    return __int_as_float(__builtin_amdgcn_update_dpp(rot, __float_as_int(cur), 0x101  , 0xf, 0xf, false)); }
struct EpiFfnIn {
    const float* c1; const float* c2;   const float* st; const float* cw; const float* cb; bf16_t* O;
    __device__ __forceinline__ void operator()(f32x4 (&acc)[2][2][4][2], const Unit& u, int wr, int wc, int fr, int fq) const {
        int T, olo, ohi, s0, s1; ht_params(2 * u.i0 + wr, T, olo, ohi, s0, s1);
        const int b = tok_b(s0), oc0 = 128 * u.i1 + 32 * wc + 8 * fq;
        {
            f32x4 k1u[2], k2u[2], k1g[2], k2g[2];
#pragma unroll
            for (int n = 0; n < 2; ++n) { k1u[n] = *(const f32x4*)(c1 + (size_t)b * 5632 + oc0 + 4 * n); k2u[n] = *(const f32x4*)(c2 + (size_t)b * 5632 + oc0 + 4 * n);
                k1g[n] = *(const f32x4*)(c1 + (size_t)b * 5632 + DFF + oc0 + 4 * n); k2g[n] = *(const f32x4*)(c2 + (size_t)b * 5632 + DFF + oc0 + 4 * n); }
#pragma unroll
            for (int ai = 0; ai < 2; ++ai)
#pragma unroll
                for (int m = 0; m < 4; ++m) { int tok = T + 64 * ai + 16 * m + fr; tok = tok < 0 ? 0 : (tok > NTOK - 1 ? NTOK - 1 : tok); float mean, rstd; row_stats(st, tok, mean, rstd);
#pragma unroll
                    for (int n = 0; n < 2; ++n)
#pragma unroll
                        for (int j = 0; j < 4; ++j) { acc[ai][0][m][n][j] = rstd * (acc[ai][0][m][n][j] - mean * k1u[n][j]) + k2u[n][j]; acc[ai][1][m][n][j] = rstd * (acc[ai][1][m][n][j] - mean * k1g[n][j]) + k2g[n][j]; } }
        }
        f32x4 w0[2], w1[2], w2[2], wb[2];
#pragma unroll
        for (int n = 0; n < 2; ++n) { w0[n] = *(const f32x4*)(cw + oc0 + 4 * n); w1[n] = *(const f32x4*)(cw + DFF + oc0 + 4 * n); w2[n] = *(const f32x4*)(cw + 2 * DFF + oc0 + 4 * n); wb[n] = *(const f32x4*)(cb + oc0 + 4 * n); }
#pragma unroll
        for (int gi = 0; gi < 8; ++gi) { const int ai = gi >> 2, m = gi & 3, gp = gi > 0 ? gi - 1 : 0, gn = gi < 7 ? gi + 1 : 7;
            const int tok = T + 64 * ai + 16 * m + fr; const bool pv = tok - 1 >= s0, nv = tok + 1 < s1, ov = tok >= olo && tok < ohi;
            f32x4 r[2];
#pragma unroll
            for (int n = 0; n < 2; ++n)
#pragma unroll
                for (int j = 0; j < 4; ++j) { const float uc = acc[ai][0][m][n][j];
                    float up = dpp_prev(uc, acc[gp >> 2][0][gp & 3][n][j]), un = dpp_next(uc, acc[gn >> 2][0][gn & 3][n][j]);
                    up = pv ? up : 0.f; un = nv ? un : 0.f;
                    const float c = w0[n][j] * up + w1[n][j] * uc + w2[n][j] * un + wb[n][j];
                    r[n][j] = gelu_f(c) * acc[ai][1][m][n][j]; }
            if (ov) *(u32x4*)((char*)O + ((unsigned)tok * (unsigned)(DFF * 2) + (unsigned)oc0 * 2u)) = pack8(r[0], r[1]); __builtin_amdgcn_sched_barrier(0); }
    }
};
__device__ __forceinline__ float2 cmul(float2 a, float2 b) { return make_float2(a.x * b.x - a.y * b.y, a.x * b.y + a.y * b.x); }

__device__ __forceinline__ void p0_mods(const Params& p, LAS unsigned char* lds, const int tid) {
    LAS float* cond = (LAS float*)lds; LAS float* red = (LAS float*)(lds + 36864);
    for (int i = tid; i < NB * D; i += NTHR) { const int b = i >> 10, k = i & 1023; const float c = b == 0 ? p.in[I_CP][k] : p.in[I_CS][(b - 1) * D + k]; cond[i] = c / (1.0f + expf(-c)); }
    __syncthreads();
    float* mods = (float*)(p.ws + WS_MODS);
    for (int item = blockIdx.x; item < 384; item += gridDim.x) {
        const int layer = item / 192, n0 = (item % 192) * 32, cl = tid & 31, ks = tid >> 5;
        const float* w = p.in[I_WADA] + (size_t)layer * D * 6144 + (size_t)(ks * 64) * 6144 + n0 + cl;
        float acc[NB];
#pragma unroll
        for (int b = 0; b < NB; ++b) acc[b] = 0.f;
        for (int k = 0; k < 64; ++k) { const float wv = w[(size_t)k * 6144];
#pragma unroll
            for (int b = 0; b < NB; ++b) acc[b] += cond[b * D + ks * 64 + k] * wv; }
#pragma unroll
        for (int b = 0; b < NB; ++b) red[(ks * 32 + cl) * NB + b] = acc[b];
        __syncthreads();
        if (tid < 288) { const int c2 = tid & 31, b = tid >> 5; float s = 0.f; for (int k2 = 0; k2 < 16; ++k2) s += red[(k2 * 32 + c2) * NB + b];
            mods[(size_t)(layer * NB + b) * 6144 + n0 + c2] = s + p.in[I_BADA][layer * 6144 + n0 + c2]; }
        __syncthreads();
    }
}
struct WDesc { const float* src; bf16_t* dst; int K, N, rows, kind, halfoff; };
__device__ __forceinline__ int wsrc_col(const WDesc& d, int np) { if (d.kind == 0) return col_of(np); const int tile = np >> 8, bj = (np >> 7) & 1, s = np & 127; return (bj ? d.halfoff : 0) + 128 * tile + col_of(s); }
__device__ __forceinline__ void p0_weights(const Params& p, LAS unsigned char* lds, const int tid) {
    LAS float* tile = (LAS float*)lds;
    WDesc ds[7];
    ds[0] = {p.in[I_WGLU], (bf16_t*)(p.ws + WS_WGLU), 1024, 2048, 2048, 1, 1024};
    ds[1] = {p.in[I_WIN], (bf16_t*)(p.ws + WS_WIN), 1024, 5632, 5632, 1, DFF};
    ds[2] = {p.in[I_WIN] + (size_t)1024 * 5632, (bf16_t*)(p.ws + WS_WIN) + (size_t)5632 * 1024, 1024, 5632, 5632, 1, DFF};
    ds[3] = {p.in[I_WOUT], (bf16_t*)(p.ws + WS_WOUT), DFF, 1024, 1024, 0, 0};
    ds[4] = {p.in[I_WOUT] + (size_t)DFF * 1024, (bf16_t*)(p.ws + WS_WOUT) + (size_t)1024 * DFF, DFF, 1024, 1024, 0, 0};
    ds[5] = {p.in[I_WQKV], (bf16_t*)(p.ws + WS_WQKV), 1024, 3072, 3072, 0, 0};
    ds[6] = {p.in[I_WO], (bf16_t*)(p.ws + WS_WO), 1024, 1024, 1024, 0, 0};
    int base = 0;
#pragma unroll
    for (int mi = 0; mi < 7; ++mi) { const WDesc d = ds[mi]; const int tk = d.K / 64, nt = (d.rows / 64) * tk;
        int first = (int)blockIdx.x - base % (int)gridDim.x; if (first < 0) first += gridDim.x;
        for (int it = first; it < nt; it += gridDim.x) { const int n0 = (it / tk) * 64, k0 = (it % tk) * 64;
            const int r = tid & 63; const int sc = wsrc_col(d, n0 + r);
#pragma unroll
            for (int j = 0; j < 8; ++j) { const int kk = (tid >> 6) + 8 * j; tile[r * 65 + kk] = d.src[(size_t)(k0 + kk) * d.N + sc]; }
            __syncthreads();
            { const int r2 = tid >> 3, kq = tid & 7; f32x4 a, b;
#pragma unroll
                for (int e = 0; e < 4; ++e) { a[e] = tile[r2 * 65 + kq * 8 + e]; b[e] = tile[r2 * 65 + kq * 8 + 4 + e]; }
                *(u32x4*)(d.dst + (size_t)(n0 + r2) * d.K + k0 + kq * 8) = pack8(a, b); }
            __syncthreads(); }
        base += nt; }
}
__device__ __forceinline__ void p0_s5tabs(const Params& p, const int tid) {
    const int gtid = blockIdx.x * NTHR + tid, gsz = gridDim.x * NTHR;
    float2* pw = (float2*)(p.ws + WS_PW); float2* bbar = (float2*)(p.ws + WS_BBAR);
    for (int i = gtid; i < 2 * 64 * 65 * 64; i += gsz) { const int pp = i & 63, tau = (i >> 6) % 65, dg = i / (64 * 65); const int idx = dg * 64 + pp;
        const double dt = exp((double)p.in[I_LDT][dg]), zr = (double)p.in[I_LRE][idx] * dt, zi = (double)p.in[I_LIM][idx] * dt; const double mag = exp(zr * tau), ang = zi * tau;
        pw[i] = make_float2((float)(mag * cos(ang)), (float)(mag * sin(ang))); }
    for (int i = gtid; i < 2 * 64 * 64 * 16; i += gsz) { const int idx = i >> 4, dg = idx >> 6;
        const double dt = exp((double)p.in[I_LDT][dg]), lr = p.in[I_LRE][idx], li = p.in[I_LIM][idx], zr = lr * dt, zi = li * dt, mag = exp(zr), abr = mag * cos(zi), abi = mag * sin(zi);
        const double den = lr * lr + li * li, nr = abr - 1.0, ni = abi, fr = (nr * lr + ni * li) / den, fi = (ni * lr - nr * li) / den; const double br = p.in[I_BRE][i], bi = p.in[I_BIM][i];
        bbar[i] = make_float2((float)(fr * br - fi * bi), (float)(fr * bi + fi * br)); }
    float* st = (float*)(p.ws + WS_STATS);
    for (int i = gtid; i < 4 * NTOK * 2; i += gsz) st[i] = 0.f;
}

__device__ __forceinline__ void p1_umat(const Params& p, LAS unsigned char* lds, const int tid) {
    const float* mods = (const float*)(p.ws + WS_MODS); bf16_t* As5 = (bf16_t*)(p.ws + WS_AS5);
    for (int tile = blockIdx.x; tile < NTOK / 16; tile += gridDim.x) { const int tok0 = tile * 16, b = tok_b(tok0); const float* m = mods + (size_t)b * 6144;
#pragma unroll
        for (int j = 0; j < 8; ++j) { const int tk = j * 2 + (tid >> 8), ch = (tid & 255) * 4; const f32x4 x = *(const f32x4*)(xin_row(p, tok0 + tk) + ch), sh = *(const f32x4*)(m + ch), sc = *(const f32x4*)(m + D + ch);
            f32x4 h; for (int e = 0; e < 4; ++e) h[e] = x[e] * (1.0f + sc[e]) + sh[e];
            u32x2 w; w.x = cvt_pk_bf16(h[0], h[1]); w.y = cvt_pk_bf16(h[2], h[3]); *(LAS u32x2*)(lds + (tk * 1024 + ch) * 2) = w; }
        __syncthreads();
        { const int g = tid >> 3, c = tile >> 2;
#pragma unroll
            for (int j = 0; j < 4; ++j) { const int q = (tid & 7) * 4 + j, tk = q >> 1, half = q & 1, s = (tile & 3) * 16 + tk;
                *(u32x4*)(As5 + ((size_t)(g * 768 + c) * 1280 + s * 16 + half * 8)) = *(const LAS u32x4*)(lds + (tk * 1024 + g * 16 + half * 8) * 2); } }
        __syncthreads(); }
}
__device__ __forceinline__ void p1_tables(const Params& p, const int tid) {
    const int gtid = blockIdx.x * NTHR + tid, gsz = gridDim.x * NTHR;
    const float2* pw = (const float2*)(p.ws + WS_PW); const float2* bbar = (const float2*)(p.ws + WS_BBAR); float* ktab = (float*)(p.ws + WS_KTAB);
    const float* cre = p.in[I_CRE]; const float* cim = p.in[I_CIM];
    for (int i = gtid; i < 2 * 64 * 64 * 256; i += gsz) { const int hp = i & 15, h = (i >> 4) & 15, tau = (i >> 8) & 63, dg = i >> 14; float s = 0.f;
        const float* cr = cre + (size_t)(dg * 16 + h) * 64; const float* ci = cim + (size_t)(dg * 16 + h) * 64; const float2* pwr = pw + (size_t)(dg * 65 + tau) * 64; const float2* bb = bbar + (size_t)dg * 64 * 16 + hp;
        for (int pp = 0; pp < 64; ++pp) { const float2 w = cmul(make_float2(cr[pp], ci[pp]), pwr[pp]); const float2 bv = bb[pp * 16]; s += w.x * bv.x - w.y * bv.y; }
        ktab[i] = s; }
    bf16_t* bsend = (bf16_t*)(p.ws + WS_BSEND);
    for (int i = gtid; i < 64 * 256 * 128; i += gsz) { const int oct = i & 127, np = (i >> 7) & 255, g = i >> 15, s = oct >> 1, half = oct & 1, col = col_of(np), seg = col >> 6, pp = col & 63, dir = seg >> 1, im = seg & 1;
        const float2 pv = pw[(size_t)((dir * 64 + g) * 65 + (dir == 0 ? 63 - s : s)) * 64 + pp]; const float2* bb = bbar + ((size_t)(dir * 64 + g) * 64 + pp) * 16 + half * 8; f32x4 a, b;
#pragma unroll
        for (int e = 0; e < 4; ++e) { const float2 x = cmul(pv, bb[e]), y = cmul(pv, bb[4 + e]); a[e] = im ? x.y : x.x; b[e] = im ? y.y : y.x; }
        *(u32x4*)(bsend + ((size_t)(g * 256 + np) * 1024 + s * 16 + half * 8)) = pack8(a, b); }
    bf16_t* bs5 = (bf16_t*)(p.ws + WS_BS5);
    for (int i = gtid; i < 64 * 1024 * 32; i += gsz) { const int oct = i & 31, np = (i >> 5) & 1023, g = i >> 15, col = col_of(np), t = col >> 4, h = col & 15, seg = oct >> 3, p0 = (oct & 7) * 8, dir = seg >> 1, im = seg & 1;
        const float* cr = cre + (size_t)((dir * 64 + g) * 16 + h) * 64 + p0; const float* ci = cim + (size_t)((dir * 64 + g) * 16 + h) * 64 + p0; const float2* pwr = pw + (size_t)((dir * 64 + g) * 65 + (dir == 0 ? t + 1 : 64 - t)) * 64 + p0; f32x4 a, b;
#pragma unroll
        for (int e = 0; e < 4; ++e) { const float2 x = cmul(make_float2(cr[e], ci[e]), pwr[e]), y = cmul(make_float2(cr[4 + e], ci[4 + e]), pwr[4 + e]); a[e] = im ? -x.y : x.x; b[e] = im ? -y.y : y.x; }
        *(u32x4*)(bs5 + ((size_t)(g * 1024 + np) * 1280 + 1024 + oct * 8)) = pack8(a, b); }
    const float* mods = (const float*)(p.ws + WS_MODS); float* gam = (float*)(p.ws + WS_GAM);
    for (int i = gtid; i < 3 * NB * D; i += gsz) { const int n = i & 1023, b = (i >> 10) % NB, j = i / (NB * D); const int layer = j == 0 ? 0 : 1, sco = j == 1 ? 1 : 4;
        gam[i] = p.in[I_LNG][j * D + n] * (1.0f + mods[(size_t)(layer * NB + b) * 6144 + sco * D + n]); }
}
__device__ __forceinline__ void p1_cvec(const Params& p, LAS unsigned char* lds, const int tid) {
    LAS float* gpr = (LAS float*)lds; LAS float* bpr = (LAS float*)(lds + 36864); LAS float* red = (LAS float*)(lds + 73728);
    const float* mods = (const float*)(p.ws + WS_MODS); float* cv = (float*)(p.ws + WS_CVEC);
    int last_sel = -1;
    for (int item = blockIdx.x; item < 448; item += gridDim.x) {
        const int sel = item < 176 ? 0 : (item < 272 ? 1 : 2), it = sel == 0 ? item : (sel == 1 ? item - 176 : item - 272);
        const int N = sel == 1 ? 3072 : 5632, layer = sel == 0 ? 0 : 1, lnj = sel, sco = sel == 1 ? 1 : 4, sho = sel == 1 ? 0 : 3;
        const float* W = sel == 0 ? p.in[I_WIN] : (sel == 1 ? p.in[I_WQKV] : p.in[I_WIN] + (size_t)1024 * 5632);
        const float* bias = sel == 0 ? p.in[I_BIN] : (sel == 1 ? p.in[I_BQKV] : p.in[I_BIN] + 5632);
        float* c1 = cv + (sel == 0 ? CV_IN0 : (sel == 1 ? CV_QKV : CV_IN1)); float* c2 = c1 + NB * N;
        if (sel != last_sel) { __syncthreads();
            for (int i = tid; i < NB * D; i += NTHR) { const int b = i >> 10, k = i & 1023; const float* m = mods + (size_t)(layer * NB + b) * 6144; const float sc = m[sco * D + k], sh = m[sho * D + k];
                gpr[i] = p.in[I_LNG][lnj * D + k] * (1.0f + sc); bpr[i] = p.in[I_LNB][lnj * D + k] * (1.0f + sc) + sh; }
            __syncthreads(); last_sel = sel; }
        const int n0 = it * 32, cl = tid & 31, ks = tid >> 5; const float* w = W + (size_t)(ks * 64) * N + n0 + cl;
        float a1[NB], a2[NB];
#pragma unroll
        for (int b = 0; b < NB; ++b) { a1[b] = 0.f; a2[b] = 0.f; }
        for (int k = 0; k < 64; ++k) { const float wv = w[(size_t)k * N];
#pragma unroll
            for (int b = 0; b < NB; ++b) { a1[b] += gpr[b * D + ks * 64 + k] * wv; a2[b] += bpr[b * D + ks * 64 + k] * wv; } }
#pragma unroll
        for (int b = 0; b < NB; ++b) { red[(ks * 32 + cl) * 18 + b] = a1[b]; red[(ks * 32 + cl) * 18 + 9 + b] = a2[b]; }
        __syncthreads();
        for (int o = tid; o < 576; o += NTHR) { const int c2i = o & 31, q = o >> 5; float s = 0.f; for (int k2 = 0; k2 < 16; ++k2) s += red[(k2 * 32 + c2i) * 18 + q];
            if (q < 9) c1[(size_t)q * N + n0 + c2i] = s; else c2[(size_t)(q - 9) * N + n0 + c2i] = s + bias[n0 + c2i]; }
        __syncthreads();
    }
}
__device__ __forceinline__ void p2_tbuild(const Params& p, const int tid) {
    const int gtid = blockIdx.x * NTHR + tid, gsz = gridDim.x * NTHR;
    const float* ktab = (const float*)(p.ws + WS_KTAB); bf16_t* bs5 = (bf16_t*)(p.ws + WS_BS5); const float* sd = p.in[I_SD];
    for (int i = gtid; i < 64 * 1024 * 128; i += gsz) { const int oct = i & 127, np = (i >> 7) & 1023, g = i >> 17, s = oct >> 1, half = oct & 1, col = col_of(np), t = col >> 4, h = col & 15;
        f32x4 a, b;
        if (t != s) { const int dir = t > s ? 0 : 1, tau = t > s ? t - s : s - t; const float* kp = ktab + ((size_t)((dir * 64 + g) * 64 + tau) * 256 + h * 16 + half * 8); a = *(const f32x4*)kp; b = *(const f32x4*)(kp + 4); }
        else { const float* kf = ktab + ((size_t)((0 * 64 + g) * 64) * 256 + h * 16 + half * 8); const float* kb = ktab + ((size_t)((1 * 64 + g) * 64) * 256 + h * 16 + half * 8);
            a = *(const f32x4*)kf + *(const f32x4*)kb; b = *(const f32x4*)(kf + 4) + *(const f32x4*)(kb + 4); const int dd = h - half * 8; const float dv = sd[g * 16 + h];
#pragma unroll
            for (int e = 0; e < 4; ++e) { if (dd == e) a[e] += dv; if (dd == 4 + e) b[e] += dv; } }
        *(u32x4*)(bs5 + ((size_t)(g * 1024 + np) * 1280 + s * 16 + half * 8)) = pack8(a, b); }
}
__device__ __forceinline__ void p3_carry(const Params& p, const int tid) {
    const int gtid = blockIdx.x * NTHR + tid, gsz = gridDim.x * NTHR;
    const float2* pw = (const float2*)(p.ws + WS_PW); const float* send = (const float*)(p.ws + WS_SEND); bf16_t* As5 = (bf16_t*)(p.ws + WS_AS5);
    for (int i = gtid; i < 2 * 64 * NB * 64; i += gsz) { const int pp = i & 63, rest = i >> 6, b = rest % NB, r2 = rest / NB, g = r2 & 63, dir = r2 >> 6;
        const float2 a64 = pw[(size_t)((dir * 64 + g) * 65 + 64) * 64 + pp]; const int c0 = seq_start(b) / 64, nch = seq_len(b) / 64;
        float2 car = make_float2(0.f, 0.f);
        for (int i0 = 0; i0 < nch; i0 += 8) { float2 sv[8];
#pragma unroll
            for (int e = 0; e < 8; ++e) { const int c = c0 + (dir == 0 ? i0 + e : nch - 1 - i0 - e); const float* sp = send + (size_t)(g * 768 + c) * 256 + dir * 128 + pp; sv[e] = make_float2(sp[0], sp[64]); }
#pragma unroll
            for (int e = 0; e < 8; ++e) { const int c = c0 + (dir == 0 ? i0 + e : nch - 1 - i0 - e); bf16_t* ap = As5 + (size_t)(g * 768 + c) * 1280 + 1024 + dir * 128 + pp; ap[0] = f2bf(car.x); ap[64] = f2bf(car.y);
                const float2 n = cmul(a64, car); car = make_float2(n.x + sv[e].x, n.y + sv[e].y); } } }
}
template <int OFF> __device__ __forceinline__ s16x4 tr_read(unsigned addr) { s16x4 r; asm volatile("ds_read_b64_tr_b16 %0, %1 offset:%2" : "=&v"(r) : "v"(addr), "i"(OFF) : "memory"); return r; }
constexpr int NA_K = 0, NA_V = 9 * 8192, NA_BIAS = 18 * 8192;
__device__ __forceinline__ void p9_attn(const Params& p, LAS unsigned char* lds, const int tid) {
    const int wid = tid >> 6, lane = tid & 63, l15 = lane & 15, g = lane >> 4, qr = wid >> 2, j = wid & 3;
    const bf16_t* qkv = (const bf16_t*)(p.ws + WS_QKV); bf16_t* o = (bf16_t*)(p.ws + WS_O);
    const int u0 = j == 0 ? 0 : (j == 1 ? 8 : (j == 2 ? 24 : 32));
    const int c = 16 * j + l15; int cs = c - 8; cs = cs < 0 ? 0 : (cs > 48 ? 48 : cs);
    LAS float* bias = (LAS float*)(lds + NA_BIAS);
    for (int item = blockIdx.x; item < 768; item += gridDim.x) {
        const int h = item & 15, rr = item >> 4; int b, R0; if (rr < 16) { b = 0; R0 = rr * 16; } else { b = 1 + ((rr - 16) >> 2); R0 = ((rr - 16) & 3) * 16; }
        const int s0 = seq_start(b), nrows = seq_len(b) / 64;
        __syncthreads();
        for (int i = tid; i < 465; i += NTHR) bias[i] = p.in[I_RPB][h * 465 + i];
        const bf16_t* kbase = qkv + 1024 + h * 64; const bf16_t* vbase = qkv + 2048 + h * 64;
        const int ltok = tid >> 3, lch = tid & 7; const unsigned lds_st = (unsigned)(ltok * 128 + ((lch ^ (ltok & 7)) * 16));
        int have_hi;
        {
            int lo = R0 - 4; lo = lo < 0 ? 0 : (lo > nrows - 8 ? nrows - 8 : lo); int hi = R0 + 1 - 4; hi = hi < 0 ? 0 : (hi > nrows - 8 ? nrows - 8 : hi); hi += 7;
            for (int kr = lo; kr <= hi; ++kr) { const size_t tk = (size_t)(s0 + kr * 64 + ltok) * 3072 + lch * 8; const u32x4 kv = *(const u32x4*)(kbase + tk), vv = *(const u32x4*)(vbase + tk);
                const unsigned so = (unsigned)((kr % 9) * 8192) + lds_st; *(LAS u32x4*)(lds + NA_K + so) = kv; *(LAS u32x4*)(lds + NA_V + so) = vv; }
            have_hi = hi; }
        __syncthreads();
        for (int pp = 0; pp < 8; ++pp) {
            const int r0 = R0 + 2 * pp;
            u32x4 nk[2], nv[2]; int nnew = 0, nlo = 0;
            if (pp < 7) { int hi = r0 + 3 - 4; hi = hi < 0 ? 0 : (hi > nrows - 8 ? nrows - 8 : hi); hi += 7; nlo = have_hi + 1; nnew = hi - have_hi;
#pragma unroll
                for (int e = 0; e < 2; ++e) if (e < nnew) { const size_t tk = (size_t)(s0 + (nlo + e) * 64 + ltok) * 3072 + lch * 8; nk[e] = *(const u32x4*)(kbase + tk); nv[e] = *(const u32x4*)(vbase + tk); } }
            const int r = r0 + qr; int rs = r - 4; rs = rs < 0 ? 0 : (rs > nrows - 8 ? nrows - 8 : rs);
            const size_t tq = (size_t)(s0 + r * 64 + c);
            bf16x8 qf[2]; qf[0] = *(const bf16x8*)(qkv + tq * 3072 + h * 64 + g * 8); qf[1] = *(const bf16x8*)(qkv + tq * 3072 + h * 64 + 32 + g * 8);
            f32x4 S[8][2];
#pragma unroll
            for (int k8 = 0; k8 < 8; ++k8) { const unsigned slot = (unsigned)(((rs + k8) % 9) * 8192);
#pragma unroll
                for (int tl = 0; tl < 2; ++tl) { const int col = u0 + 16 * tl + l15; f32x4 a = (f32x4){0.f, 0.f, 0.f, 0.f};
#pragma unroll
                    for (int ks = 0; ks < 2; ++ks) { const bf16x8 kf = *(const LAS bf16x8*)(lds + NA_K + slot + col * 128 + (((g + 4 * ks) ^ (col & 7)) * 16)); a = __builtin_amdgcn_mfma_f32_16x16x32_bf16(kf, qf[ks], a, 0, 0, 0); }
                    S[k8][tl] = a; } }
            float mx = -3.0e38f;
#pragma unroll
            for (int k8 = 0; k8 < 8; ++k8)
#pragma unroll
                for (int tl = 0; tl < 2; ++tl)
#pragma unroll
                    for (int e = 0; e < 4; ++e) { const int kc = u0 + 16 * tl + 4 * g + e; const bool ok = kc >= cs && kc <= cs + 15; int bi = (rs + k8 - r + 7) * 31 + (kc - c + 15); bi = ok ? bi : 0;
                        const float sv = ok ? S[k8][tl][e] + bias[bi] : -3.0e38f; S[k8][tl][e] = sv; mx = fmaxf(mx, sv); }
            mx = fmaxf(mx, __shfl_xor(mx, 16)); mx = fmaxf(mx, __shfl_xor(mx, 32));
            float sum = 0.f;
#pragma unroll
            for (int k8 = 0; k8 < 8; ++k8)
#pragma unroll
                for (int tl = 0; tl < 2; ++tl)
#pragma unroll
                    for (int e = 0; e < 4; ++e) { const float pe = __expf(S[k8][tl][e] - mx); S[k8][tl][e] = pe; sum += pe; }
            sum += __shfl_xor(sum, 16); sum += __shfl_xor(sum, 32);
            const float inv = 1.0f / sum;
            f32x4 O[4];
#pragma unroll
            for (int dt = 0; dt < 4; ++dt) O[dt] = (f32x4){0.f, 0.f, 0.f, 0.f};
#pragma unroll
            for (int k8 = 0; k8 < 8; ++k8) { const unsigned slot = (unsigned)(((rs + k8) % 9) * 8192);
                const u32x4 pk = pack8(S[k8][0] * inv, S[k8][1] * inv); bf16x8 pf; __builtin_memcpy(&pf, &pk, 16);
                const int col0 = u0 + 4 * g + (l15 >> 2), col1 = col0 + 16;
#pragma unroll
                for (int dt = 0; dt < 4; ++dt) { const int ch = dt * 2 + ((l15 & 3) >> 1);
                    const unsigned a0 = (unsigned)(NA_V) + slot + (unsigned)(col0 * 128 + ((ch ^ (col0 & 7)) * 16) + (l15 & 1) * 8), a1 = (unsigned)(NA_V) + slot + (unsigned)(col1 * 128 + ((ch ^ (col1 & 7)) * 16) + (l15 & 1) * 8);
                    const s16x4 v0 = tr_read<0>(a0), v1 = tr_read<0>(a1);
                    asm volatile("s_waitcnt lgkmcnt(0)" ::: "memory"); __builtin_amdgcn_sched_barrier(0);
                    const bf16x8 vf = (bf16x8){v0[0], v0[1], v0[2], v0[3], v1[0], v1[1], v1[2], v1[3]};
                    O[dt] = __builtin_amdgcn_mfma_f32_16x16x32_bf16(vf, pf, O[dt], 0, 0, 0); } }
#pragma unroll
            for (int dt = 0; dt < 4; ++dt) { u32x2 w; w.x = cvt_pk_bf16(O[dt][0], O[dt][1]); w.y = cvt_pk_bf16(O[dt][2], O[dt][3]); *(u32x2*)(o + tq * D + h * 64 + dt * 16 + 4 * g) = w; }
            __syncthreads();
#pragma unroll
            for (int e = 0; e < 2; ++e) if (e < nnew) { const unsigned so = (unsigned)(((nlo + e) % 9) * 8192) + lds_st; *(LAS u32x4*)(lds + NA_K + so) = nk[e]; *(LAS u32x4*)(lds + NA_V + so) = nv[e]; }
            have_hi += nnew;
            __syncthreads();
        }
    }
}
__device__ __forceinline__ void p13_final(const Params& p, const int tid) {
    const int wv = blockIdx.x * (NTHR / 64) + (tid >> 6), nwv = gridDim.x * (NTHR / 64), lane = tid & 63;
    const float* lng = p.in[I_LNG] + 3 * D; const float* lnb = p.in[I_LNB] + 3 * D;
    for (int row = wv; row < NTOK; row += nwv) { float* v = p.out + (size_t)row * D; f32x4 x[4];
#pragma unroll
        for (int q = 0; q < 4; ++q) x[q] = *(const f32x4*)(v + q * 256 + lane * 4);
        float s = 0.f;
#pragma unroll
        for (int q = 0; q < 4; ++q) s += (x[q][0] + x[q][1]) + (x[q][2] + x[q][3]);
        for (int o = 32; o >= 1; o >>= 1) s += __shfl_xor(s, o);
        const float mean = s * (1.0f / D); float q2 = 0.f;
#pragma unroll
        for (int q = 0; q < 4; ++q) { const f32x4 d = x[q] - mean; q2 += (d[0] * d[0] + d[1] * d[1]) + (d[2] * d[2] + d[3] * d[3]); }
        for (int o = 32; o >= 1; o >>= 1) q2 += __shfl_xor(q2, o);
        const float rstd = rsqrtf(q2 * (1.0f / D) + LN_EPS);
#pragma unroll
        for (int q = 0; q < 4; ++q) { const int n = q * 256 + lane * 4; const f32x4 gg = *(const f32x4*)(lng + n), bb = *(const f32x4*)(lnb + n); *(f32x4*)(v + n) = (x[q] - mean) * rstd * gg + bb; } }
}
__device__ __forceinline__ void ph_gemm_send(const Params& p, LAS unsigned char* lds, const int tid) {
    SchedS5 S; S.o.init(192, 1, gridDim.x, blockIdx.x); S.A = (const char*)(p.ws + WS_AS5); S.B = (const char*)(p.ws + WS_BSEND); S.b_gstride = (size_t)256 * 2048; S.b_rs = 2048;
    const GShape g{16, 2560u, 32u, 2048u}; const EpiSend E{(float*)(p.ws + WS_SEND)};
    gemm_phase(lds, g, S, E, tid);
}
__device__ __forceinline__ void ph_gemm_s5(const Params& p, LAS unsigned char* lds, const int tid) {
    SchedS5 S; S.o.init(192, 4, gridDim.x, blockIdx.x); S.A = (const char*)(p.ws + WS_AS5); S.B = (const char*)(p.ws + WS_BS5); S.b_gstride = (size_t)1024 * 2560; S.b_rs = 2560;
    const GShape g{20, 2560u, 32u, 2560u}; const EpiS5 E{(bf16_t*)(p.ws + WS_YG)};
    gemm_phase(lds, g, S, E, tid);
}
__device__ __forceinline__ void ph_gemm_glu(const Params& p, LAS unsigned char* lds, const int tid) {
    SchedPlain S; S.o.init(192, 8, gridDim.x, blockIdx.x); S.A = (const char*)(p.ws + WS_YG); S.B = (const char*)(p.ws + WS_WGLU); S.a_rs = 32; S.b_rs = 2048;
    const GShape g{16, 32u, (unsigned)(NTOK * 32), 2048u};
    const EpiGlu E{p.in[I_XP], p.in[I_XS], p.out, p.in[I_BGLU], (const float*)(p.ws + WS_MODS), (const float*)(p.ws + WS_GAM), (float*)(p.ws + WS_STATS), (bf16_t*)(p.ws + WS_APR)};
    gemm_phase(lds, g, S, E, tid);
}
__device__ __forceinline__ void ph_gemm_ffn_in(const Params& p, LAS unsigned char* lds, const int tid, int layer) {
    SchedFfnIn S; S.o.init(FFN_UNITS_M, 22, gridDim.x, blockIdx.x); S.A = (const char*)(p.ws + (layer == 0 ? WS_APR : WS_APR3)); S.B = (const char*)(p.ws + WS_WIN) + (size_t)layer * 5632 * 2048;
    const GShape g{16, 2048u, 32u, 2048u};
    const float* c1 = (const float*)(p.ws + WS_CVEC) + (layer == 0 ? CV_IN0 : CV_IN1);
    const EpiFfnIn E{c1, c1 + NB * 5632, (const float*)(p.ws + WS_STATS) + (size_t)(layer == 0 ? 0 : 2) * NTOK * 2, p.in[I_CW] + (size_t)layer * 3 * DFF, p.in[I_CB] + (size_t)layer * DFF, (bf16_t*)(p.ws + (layer == 0 ? WS_A0 : WS_A1))};
    gemm_phase(lds, g, S, E, tid);
}
__device__ __forceinline__ void ph_gemm_ffn_out(const Params& p, LAS unsigned char* lds, const int tid, int layer) {
    SchedPlain S; S.o.init(192, 4, gridDim.x, blockIdx.x); S.A = (const char*)(p.ws + (layer == 0 ? WS_A0 : WS_A1)); S.B = (const char*)(p.ws + WS_WOUT) + (size_t)layer * 1024 * 5632; S.a_rs = 5632; S.b_rs = 5632;
    const GShape g{44, 5632u, 32u, 5632u};
    const float* mods_l = (const float*)(p.ws + WS_MODS) + (size_t)layer * NB * 6144; float* st = (float*)(p.ws + WS_STATS);
    const EpiOut E{p.out, p.in[I_BOUT] + layer * D, p.in[I_LNG] + (layer * 2) * D, p.in[I_LNB] + (layer * 2) * D, mods_l + 5 * D, layer == 0 ? (const float*)(p.ws + WS_GAM) + NB * D : nullptr,
                   st + (size_t)(layer == 0 ? 0 : 2) * NTOK * 2, layer == 0 ? st + (size_t)1 * NTOK * 2 : nullptr, layer == 0 ? (bf16_t*)(p.ws + WS_APR) : nullptr};
    gemm_phase(lds, g, S, E, tid);
}
__device__ __forceinline__ void ph_gemm_qkv(const Params& p, LAS unsigned char* lds, const int tid) {
    SchedPlain S; S.o.init(192, 12, gridDim.x, blockIdx.x); S.A = (const char*)(p.ws + WS_APR); S.B = (const char*)(p.ws + WS_WQKV); S.a_rs = 2048; S.b_rs = 2048;
    const GShape g{16, 2048u, 32u, 2048u}; const float* c1 = (const float*)(p.ws + WS_CVEC) + CV_QKV;
    const EpiQkv E{c1, c1 + NB * 3072, (const float*)(p.ws + WS_STATS) + (size_t)1 * NTOK * 2, (bf16_t*)(p.ws + WS_QKV)};
    gemm_phase(lds, g, S, E, tid);
}
__device__ __forceinline__ void ph_gemm_wo(const Params& p, LAS unsigned char* lds, const int tid) {
    SchedPlain S; S.o.init(192, 4, gridDim.x, blockIdx.x); S.A = (const char*)(p.ws + WS_O); S.B = (const char*)(p.ws + WS_WO); S.a_rs = 2048; S.b_rs = 2048;
    const GShape g{16, 2048u, 32u, 2048u};
    const float* mods_l = (const float*)(p.ws + WS_MODS) + (size_t)1 * NB * 6144; float* st = (float*)(p.ws + WS_STATS);
    const EpiOut E{p.out, p.in[I_BO], p.in[I_LNG] + 1 * D, p.in[I_LNB] + 1 * D, mods_l + 2 * D, (const float*)(p.ws + WS_GAM) + 2 * NB * D, st + (size_t)1 * NTOK * 2, st + (size_t)2 * NTOK * 2, (bf16_t*)(p.ws + WS_APR3)};
    gemm_phase(lds, g, S, E, tid);
}

#define XB_TMO      128
#define XB_XCNT(j)  (256  + 64 * (j))
#define XB_XSUB(j)  (1280 + 64 * (j))
#define XB_XGEN(j)  (2304 + 64 * (j))
#define XB_TOP      3328
#define XB_TOPGEN   3392
#define XCD_BAR_WORDS 3456
#define XB_SPIN_CAP (1u << 18)
__device__ __forceinline__ unsigned xb_ld(unsigned* p)              { return __hip_atomic_load(p, __ATOMIC_RELAXED, __HIP_MEMORY_SCOPE_AGENT); }
__device__ __forceinline__ unsigned xb_add(unsigned* p, unsigned v) { return __hip_atomic_fetch_add(p, v, __ATOMIC_RELAXED, __HIP_MEMORY_SCOPE_AGENT); }
__device__ __forceinline__ unsigned xb_xcc_id() { return (unsigned)__builtin_amdgcn_s_getreg((3 << 11) | 20) & 0xFu; }
#define XB_SPIN(cond, bar) do { unsigned _sp = 0; while (cond) { __builtin_amdgcn_s_sleep(1); \
    if ((++_sp & 255u) == 0u) { if (xb_ld(&(bar)[XB_TMO])) break; if (_sp > XB_SPIN_CAP) { atomicAdd(&(bar)[XB_TMO], 1u); break; } } } } while (0)
struct XcdBarrier { unsigned* bar; unsigned x; volatile LAS unsigned* st; int wid0; };
__device__ __forceinline__ XcdBarrier xcd_barrier_post(unsigned* bar, volatile LAS unsigned* st, const int wid0) {
    XcdBarrier b; b.bar = bar; b.x = xb_xcc_id(); b.st = st; b.wid0 = wid0;
    if (wid0 == 0 && lane_id_asm() == 0) (void)xb_add(&bar[XB_XCNT(b.x)], 1u);
    return b;
}
__device__ __forceinline__ void xcd_barrier_complete(unsigned* bar, unsigned x, unsigned& nloc, unsigned& nx) {
    const unsigned G = gridDim.x * gridDim.y * gridDim.z;
    unsigned sum, cnt, mine, sp = 0u;
    for (;;) {
        sum = 0u; cnt = 0u; mine = 0u;
#pragma unroll
        for (unsigned j = 0; j < 16; ++j) { const unsigned c = xb_ld(&bar[XB_XCNT(j)]); sum += c; cnt += (c > 0u) ? 1u : 0u; mine = (j == x) ? c : mine; }
        if (sum == G) break;
        __builtin_amdgcn_s_sleep(1);
        if ((++sp & 255u) == 0u) { if (xb_ld(&bar[XB_TMO])) break; if (sp > XB_SPIN_CAP) { atomicAdd(&bar[XB_TMO], 1u); break; } }
    }
    nloc = mine > 0u ? mine : 1u; nx = cnt > 0u ? cnt : 1u;
}
__device__ __forceinline__ void xcd_barrier(const XcdBarrier& b) {
    asm volatile("s_waitcnt vmcnt(0)" ::: "memory");
    __syncthreads();
    if (b.wid0 == 0 && lane_id_asm() == 0) {
        unsigned* bar = b.bar;
        __builtin_amdgcn_s_waitcnt(0);
        unsigned nloc = b.st[0], nx = b.st[1];
        if (nloc == 0u) { xcd_barrier_complete(bar, b.x, nloc, nx); b.st[0] = nloc; b.st[1] = nx; }
        const unsigned old = xb_add(&bar[XB_XSUB(b.x)], 1u);
        const unsigned gen = old / nloc;
        if (old + 1u == (gen + 1u) * nloc) {
            __builtin_amdgcn_fence(__ATOMIC_RELEASE, "agent");
            asm volatile("s_waitcnt vmcnt(0)" ::: "memory");
            const unsigned og = xb_add(&bar[XB_TOP], 1u);
            const unsigned tg = og / nx;
            if (og + 1u == (tg + 1u) * nx) xb_add(&bar[XB_TOPGEN], 1u);
            else XB_SPIN(xb_ld(&bar[XB_TOPGEN]) == tg, bar);
            __builtin_amdgcn_fence(__ATOMIC_ACQUIRE, "agent");
            xb_add(&bar[XB_XGEN(b.x)], 1u);
            asm volatile("s_waitcnt vmcnt(0)" ::: "memory");
        } else {
            XB_SPIN(xb_ld(&bar[XB_XGEN(b.x)]) == gen, bar);
            __builtin_amdgcn_fence(__ATOMIC_ACQUIRE, "agent");
            asm volatile("s_waitcnt vmcnt(0)" ::: "memory");
        }
    }
    __syncthreads();
}

constexpr int LDS_BYTES = 152 * 1024, LDS_MISC = 150 * 1024;
constexpr int N_PHASES = 14;
__global__ void __launch_bounds__(NTHR, 2) k_fwd(Params p, int lo, int hi) {
    extern __shared__ __attribute__((aligned(16))) unsigned char lds_raw[];
    LAS unsigned char* lds = (LAS unsigned char*)lds_raw;
    volatile LAS unsigned* misc = (volatile LAS unsigned*)(lds + LDS_MISC);
    const int wid0 = __builtin_amdgcn_readfirstlane((int)threadIdx.x >> 6);
    if (threadIdx.x < 4) misc[threadIdx.x] = 0u;
    __syncthreads();
    XcdBarrier bar; bar.bar = (unsigned*)(p.ws + WS_CTL); bar.x = 0; bar.st = misc; bar.wid0 = wid0;
    const bool multi = (hi - lo) > 1;
    if (multi) bar = xcd_barrier_post((unsigned*)(p.ws + WS_CTL), misc, wid0);
#define PH(k) (lo <= (k) && (k) < hi)
#define SEAM(k) do { if (PH(k) && PH((k) + 1)) { if ((k) == 0) cg::this_grid().sync(); else xcd_barrier(bar); } } while (0)
#define TID (wid0 * 64 + lane_id_asm())
    if (PH(0)) { const int tid = TID; p0_mods(p, lds, tid); __syncthreads(); p0_weights(p, lds, tid); p0_s5tabs(p, tid); } SEAM(0);
    if (PH(1)) { const int tid = TID; p1_umat(p, lds, tid); p1_tables(p, tid); __syncthreads(); p1_cvec(p, lds, tid); } SEAM(1);
    if (PH(2)) { const int tid = TID; ph_gemm_send(p, lds, tid); p2_tbuild(p, tid); } SEAM(2);
    if (PH(3)) { p3_carry(p, TID); } SEAM(3);
    if (PH(4)) { ph_gemm_s5(p, lds, TID); } SEAM(4);
    if (PH(5)) { ph_gemm_glu(p, lds, TID); } SEAM(5);
    if (PH(6)) { ph_gemm_ffn_in(p, lds, TID, 0); } SEAM(6);
    if (PH(7)) { ph_gemm_ffn_out(p, lds, TID, 0); } SEAM(7);
    if (PH(8)) { ph_gemm_qkv(p, lds, TID); } SEAM(8);
    if (PH(9)) { p9_attn(p, lds, TID); } SEAM(9);
    if (PH(10)) { ph_gemm_wo(p, lds, TID); } SEAM(10);
    if (PH(11)) { ph_gemm_ffn_in(p, lds, TID, 1); } SEAM(11);
    if (PH(12)) { ph_gemm_ffn_out(p, lds, TID, 1); } SEAM(12);
    if (PH(13)) { p13_final(p, TID); }
#undef TID
#undef PH
#undef SEAM
}
#ifndef MK_NOPT
#define MK_NOPT 5
#endif
#ifndef MK_ONE
#define MK_ONE 1
#endif
static void naive_tail(int first_stage, void* const* d_in, float* out, char* ws, hipStream_t stream) {
    using namespace nk;
    const float* xp = (const float*)d_in[0]; const float* xs = (const float*)d_in[1]; const float* cp = (const float*)d_in[2]; const float* cs = (const float*)d_in[3];
    const float* w_ada = (const float*)d_in[4]; const float* b_ada = (const float*)d_in[5]; const float* ln_g = (const float*)d_in[6]; const float* ln_b = (const float*)d_in[7];
    const float* lam_re = (const float*)d_in[8]; const float* lam_im = (const float*)d_in[9]; const float* log_dt = (const float*)d_in[10];
    const float* b_re = (const float*)d_in[11]; const float* b_im = (const float*)d_in[12]; const float* c_re = (const float*)d_in[13]; const float* c_im = (const float*)d_in[14];
    const float* s5_d = (const float*)d_in[15]; const float* w_glu = (const float*)d_in[16]; const float* b_glu = (const float*)d_in[17];
    const float* w_qkv = (const float*)d_in[18]; const float* b_qkv = (const float*)d_in[19]; const float* rpb = (const float*)d_in[20]; const float* w_o = (const float*)d_in[21]; const float* b_o = (const float*)d_in[22];
    const float* w_in = (const float*)d_in[23]; const float* b_in = (const float*)d_in[24]; const float* conv_w = (const float*)d_in[25]; const float* conv_b = (const float*)d_in[26];
    const float* w_out = (const float*)d_in[27]; const float* b_out = (const float*)d_in[28];
    const size_t MB = 1ull << 20;
    float* H = (float*)(ws); float* R1 = (float*)(ws + 192 * MB); float* mods = (float*)(ws + 400 * MB);
    const int CH = 4096;
    if (first_stage > 4) return;
    nk_mods<<<48, 256, 0, stream>>>(cp, cs, w_ada, b_ada, mods);
    if (first_stage <= 0) {
        nk_ln_mod<<<NTOK / 4, 256, 0, stream>>>(xp, xs, nullptr, 0, nullptr, nullptr, mods, 0, 1, H);
        float* Y = R1;
        nk_dskip<<<NTOK * D / 256, 256, 0, stream>>>(H, s5_d, Y);
        nk_s5_scan<<<NB * 64, 64, 0, stream>>>(H, Y, 0, lam_re, lam_im, log_dt, b_re, b_im, c_re, c_im);
        nk_s5_scan<<<NB * 64, 64, 0, stream>>>(H, Y, 1, lam_re, lam_im, log_dt, b_re, b_im, c_re, c_im);
        for (int c0 = 0; c0 < NTOK; c0 += CH) { float* AG = H;
            nk_gemm<1><<<dim3(2048 / 64, CH / 64), 256, 0, stream>>>(Y + (size_t)c0 * D, D, w_glu, 2048, b_glu, AG, 2048, CH, 2048, D);
            nk_residual<<<CH / 4, 256, 0, stream>>>(xp, xs, out, 0, nullptr, nullptr, mods, 2, AG, 1, c0, nullptr); }
    }
    for (int layer = 0; layer < 2; ++layer) {
        const float* mods_l = mods + (size_t)layer * NB * 6144;
        if (layer == 1 && first_stage <= 2) {
            const float* lg = ln_g + 1 * D; const float* lb = ln_b + 1 * D;
            nk_ln_mod<<<NTOK / 4, 256, 0, stream>>>(xp, xs, out, 1, lg, lb, mods_l, 0, 1, H);
            float* QKV = R1; float* Oc = R1 + (size_t)80 * MB / 4; float* Yc = R1 + (size_t)100 * MB / 4;
            for (int c0 = 0; c0 < NTOK; c0 += CH) { const int b = tok_b(c0), s0 = seq_start(b), s1 = s0 + seq_len(b);
                int k0 = c0 - 7 * 64; if (k0 < s0) k0 = s0; int k1 = c0 + CH + 7 * 64; if (k1 > s1) k1 = s1; const int kr = k1 - k0;
                nk_gemm<0><<<dim3(3072 / 64, (kr + 63) / 64), 256, 0, stream>>>(H + (size_t)k0 * D, D, w_qkv, 3072, b_qkv, QKV, 3072, kr, 3072, D);
                nk_na_attn<<<CH * 16 / 4, 256, 0, stream>>>(QKV, k0, c0, rpb, Oc);
                nk_gemm<0><<<dim3(D / 64, CH / 64), 256, 0, stream>>>(Oc, D, w_o, D, b_o, Yc, D, CH, D, D);
                nk_residual<<<CH / 4, 256, 0, stream>>>(xp, xs, out, 1, lg, lb, mods_l, 2, Yc, 0, c0, nullptr); }
        }
        if (first_stage > (layer == 0 ? 1 : 3)) continue;
        const float* lg = ln_g + (layer * 2 + 0) * D; const float* lb = ln_b + (layer * 2 + 0) * D;
        nk_ln_mod<<<NTOK / 4, 256, 0, stream>>>(xp, xs, out, 1, lg, lb, mods_l, 3, 4, H);
        float* UG = R1; float* Ac = R1 + (size_t)96 * MB / 4; float* Yc = R1 + (size_t)144 * MB / 4;
        const float* wi = w_in + (size_t)layer * D * 2 * DFF; const float* bi = b_in + (size_t)layer * 2 * DFF;
        const float* cw = conv_w + (size_t)layer * 3 * DFF; const float* cb = conv_b + (size_t)layer * DFF;
        const float* wo = w_out + (size_t)layer * DFF * D; const float* bo = b_out + (size_t)layer * D;
        for (int c0 = 0; c0 < NTOK; c0 += CH) { const int b = tok_b(c0), s0 = seq_start(b), s1 = s0 + seq_len(b);
            int u0 = c0 - 1; if (u0 < s0) u0 = s0; int u1 = c0 + CH + 1; if (u1 > s1) u1 = s1; const int ur = u1 - u0;
            nk_gemm<0><<<dim3(2 * DFF / 64, (ur + 63) / 64), 256, 0, stream>>>(H + (size_t)u0 * D, D, wi, 2 * DFF, bi, UG, 2 * DFF, ur, 2 * DFF, D);
            nk_convgate<<<(CH * DFF + 255) / 256, 256, 0, stream>>>(UG, u0, c0, CH, cw, cb, Ac);
            nk_gemm<0><<<dim3(D / 64, CH / 64), 256, 0, stream>>>(Ac, DFF, wo, D, bo, Yc, D, CH, D, DFF);
            nk_residual<<<CH / 4, 256, 0, stream>>>(xp, xs, out, 1, lg, lb, mods_l, 5, Yc, 0, c0, nullptr); }
    }
    nk_final_ln<<<NTOK / 4, 256, 0, stream>>>(out, ln_g + 3 * D, ln_b + 3 * D);
}

extern "C" void kernel_launch(void* const* d_in, const int* in_sizes, int n_in, void* d_out, int out_size, void* d_ws, size_t ws_size, hipStream_t stream) {
    static int grid = 0;
    if (grid == 0) {
        if (n_in != 29 || out_size != NTOK * D || ws_size < WS_NEED) { fprintf(stderr, "kernel_launch: unexpected problem (n_in %d, out %d, ws %zu < %zu)\n", n_in, out_size, ws_size, (size_t)WS_NEED); grid = -1; return; }
        int dev = 0, cus = 0, per_cu = 0;
        hipGetDevice(&dev); hipDeviceGetAttribute(&cus, hipDeviceAttributeMultiprocessorCount, dev);
        if (hipFuncSetAttribute((const void*)k_fwd, hipFuncAttributeMaxDynamicSharedMemorySize, LDS_BYTES) != hipSuccess) { fprintf(stderr, "kernel_launch: hipFuncSetAttribute failed\n"); grid = -1; return; }
        hipOccupancyMaxActiveBlocksPerMultiprocessor(&per_cu, (const void*)k_fwd, NTHR, LDS_BYTES);
        if (per_cu < 1) { fprintf(stderr, "kernel_launch: occupancy query reports %d blocks per CU\n", per_cu); (void)hipGetLastError(); }
        grid = cus;
    }
    if (grid < 0) return;
    Params p{};
    for (int i = 0; i < 29; ++i) p.in[i] = (const float*)d_in[i];
    p.out = (float*)d_out; p.ws = (unsigned char*)d_ws;
    const int stage_end[6] = {0, 6, 8, 11, 13, 14};
    const int nph = stage_end[MK_NOPT];
    if (nph > 0) {
        (void)hipMemsetAsync((char*)d_ws + WS_CTL, 0, 64 * 1024, stream);
        if (MK_ONE && MK_NOPT == 5) {
            int lo = 0, hi = N_PHASES; void* args[] = {&p, &lo, &hi};
            hipError_t e = hipLaunchCooperativeKernel((const void*)k_fwd, dim3(grid), dim3(NTHR), args, LDS_BYTES, stream);
            if (e != hipSuccess) fprintf(stderr, "cooperative launch failed: %s (grid %d)\n", hipGetErrorString(e), grid);
        } else {
            for (int ph = 0; ph < nph; ++ph) hipLaunchKernelGGL(k_fwd, dim3(grid), dim3(NTHR), LDS_BYTES, stream, p, ph, ph + 1);
        }
    }
    naive_tail(MK_NOPT, d_in, (float*)d_out, (char*)d_ws, stream);
}
```

```cpp
#define MK_NOPT 5
#define MK_ONE 1
#include <hip/hip_runtime.h>
#include <hip/hip_cooperative_groups.h>
#include <cstdio>
#include <math.h>
namespace cg = cooperative_groups;
#define LAS __attribute__((address_space(3)))
typedef unsigned short bf16_t;
typedef short bf16x8 __attribute__((ext_vector_type(8)));
typedef short s16x4 __attribute__((ext_vector_type(4)));
typedef float f32x4 __attribute__((ext_vector_type(4)));
typedef unsigned u32x4 __attribute__((ext_vector_type(4)));
typedef unsigned u32x2 __attribute__((ext_vector_type(2)));

constexpr int NTOK = 49152, D = 1024, NB = 9, DFF = 2816, NPROMPT = 16384, SSEQ = 4096;
constexpr float ALPHA = 1.41421356237309515f;
constexpr float LN_EPS = 1e-5f;
constexpr int NTHR = 512;

__device__ __host__ inline int tok_b(int t) { return t < NPROMPT ? 0 : 1 + ((t - NPROMPT) >> 12); }
__device__ __host__ inline int seq_start(int b) { return b == 0 ? 0 : NPROMPT + (b - 1) * SSEQ; }
__device__ __host__ inline int seq_len(int b) { return b == 0 ? NPROMPT : SSEQ; }

__device__ __forceinline__ unsigned cvt_pk_bf16(float lo, float hi) { unsigned r; asm volatile("v_cvt_pk_bf16_f32 %0, %1, %2" : "=v"(r) : "v"(lo), "v"(hi)); return r; }
__device__ __forceinline__ bf16_t f2bf(float f) { return (bf16_t)(cvt_pk_bf16(f, 0.f) & 0xffffu); }
__device__ __forceinline__ float sigmoid_f(float x) { return __builtin_amdgcn_rcpf(1.0f + __expf(-x)); }
__device__ __forceinline__ float gelu_f(float x) { const float u2 = 1.5957691216057308f * x * (1.0f + 0.044715f * x * x); return x * __builtin_amdgcn_rcpf(1.0f + __expf(-u2)); }
__device__ __forceinline__ u32x4 pack8(const f32x4& a, const f32x4& b) { u32x4 w; w.x = cvt_pk_bf16(a[0], a[1]); w.y = cvt_pk_bf16(a[2], a[3]); w.z = cvt_pk_bf16(b[0], b[1]); w.w = cvt_pk_bf16(b[2], b[3]); return w; }
__device__ __forceinline__ int lane_id_asm() { int l_; asm volatile("v_mbcnt_lo_u32_b32 %0, -1, 0\n\tv_mbcnt_hi_u32_b32 %0, -1, %0" : "=v"(l_)); return l_; }
__device__ __forceinline__ void atomic_add_f32(float* p, float v) { (void)__hip_atomic_fetch_add(p, v, __ATOMIC_RELAXED, __HIP_MEMORY_SCOPE_AGENT); }

constexpr int BK = 64, HTB = 128 * BK * 2  , STAGE_BYTES = 8 * HTB, NXCD = 8, WGM = 8;
__host__ __device__ __forceinline__ int lds_byte(int r, int c) { const int st = (r >> 4) * 2 + (c >> 5), rr = r & 15, cc = c & 31, ob = rr * 64 + cc * 2; return st * 1024 + (ob ^ (((ob >> 9) & 1) << 5)); }
__host__ __device__ __forceinline__ void stage_rc(int b, int& R, int& C) { const int st = b / 1024, sb = b % 1024, swz = sb ^ (((sb >> 9) & 1) << 5); R = (st >> 1) * 16 + swz / 64; C = (st & 1) * 32 + (swz % 64) / 2; }
__host__ __device__ __forceinline__ int perm32(int rho) { const int n = rho >> 4, i = rho & 15; return 8 * (i >> 2) + 4 * n + (i & 3); }
__host__ __device__ __forceinline__ int col_of(int np) { return (np & ~31) + perm32(np & 31); }

struct Unit { const char* a0; const char* a1; const char* b; int i0, i1; };
struct GShape { int nt; unsigned a_rs, a_gs, b_rs; };

struct TileOrder {
    int nM, nN, nwg, G, c;
    __device__ void init(int nM_, int nN_, int G_, int c_) { nM = nM_; nN = nN_; nwg = nM * nN; G = G_; c = c_; }
    __device__ bool get(int i, int& pm, int& pn) const {
        const long L = (long)i * G + c; if (L >= nwg) return false;
        int wgid = (int)L; { const int q = nwg / NXCD, r = nwg % NXCD, xcd = wgid % NXCD, off = wgid / NXCD; wgid = (xcd < r ? xcd * (q + 1) : r * (q + 1) + (xcd - r) * q) + off; }
        const int nig = WGM * nN, gid = wgid / nig, fm = gid * WGM, gsz = (nM - fm) < WGM ? (nM - fm) : WGM;
        pm = fm + ((wgid % nig) % gsz); pn = (wgid % nig) / gsz; return true;
    }
};

template <class Epi, class Sched>
__device__ __forceinline__ void gemm_phase(LAS unsigned char* lds, const GShape g, const Sched& S, const Epi& E, const int tid) {
    const int wid = __builtin_amdgcn_readfirstlane(tid >> 6), lane = tid & 63, wr = wid >> 2, wc = wid & 3, fr = lane & 15, fq = lane >> 4;
    const int nt = g.nt;
    unsigned voffA[2], voffB[2];
#pragma unroll
    for (int i = 0; i < 2; ++i) { int R, C; stage_rc(tid * 16 + i * 8192, R, C);
        voffA[i] = (unsigned)(R & 63) * g.a_rs + (unsigned)(C >> 4) * g.a_gs + (unsigned)(C & 15) * 2u; voffB[i] = (unsigned)R * g.b_rs + (unsigned)C * 2u; }
    const size_t kstepA = (size_t)g.a_gs * 4, kstepB = (size_t)(BK * 2);
    const size_t hstepA = (size_t)g.a_rs * 64, hstepB = (size_t)g.b_rs * 128;
    const unsigned ldsw = (unsigned)wid * 1024u;
    const int aoff = lds_byte(wr * 64 + fr, fq * 8), boff = lds_byte(wc * 32 + fr, fq * 8);
#define G_SA(b, h) (((b) * 2 + (h)) * HTB)
#define G_SB(b, h) ((4 + (b) * 2 + (h)) * HTB)
#define G_GLDS(src, dstoff) __builtin_amdgcn_global_load_lds((const unsigned*)(src), (LAS unsigned*)(lds + (dstoff)), 16, 0, 0)
#define G_STAGE_A(bufoff, p0, p1) do { G_GLDS((p0) + voffA[0], (bufoff) + ldsw); G_GLDS((p1) + voffA[1], (bufoff) + ldsw + 8192); } while (0)
#define G_STAGE_B(bufoff, pb) do { G_GLDS((pb) + voffB[0], (bufoff) + ldsw); G_GLDS((pb) + voffB[1], (bufoff) + ldsw + 8192); } while (0)
#define G_LDA(dst, b, h) do { _Pragma("unroll") for (int m = 0; m < 4; ++m) _Pragma("unroll") for (int k = 0; k < 2; ++k) dst[m][k] = *(const LAS bf16x8*)(lds + G_SA(b, h) + aoff + m * 2048 + k * 1024); } while (0)
#define G_LDB(dst, b, h) do { _Pragma("unroll") for (int n = 0; n < 2; ++n) _Pragma("unroll") for (int k = 0; k < 2; ++k) dst[n][k] = *(const LAS bf16x8*)(lds + G_SB(b, h) + boff + n * 2048 + k * 1024); } while (0)
#define G_MMA(ai, bj, At, Bt) do { __builtin_amdgcn_s_setprio(1); _Pragma("unroll") for (int m = 0; m < 4; ++m) _Pragma("unroll") for (int n = 0; n < 2; ++n) _Pragma("unroll") for (int k = 0; k < 2; ++k) \
        acc[ai][bj][m][n] = __builtin_amdgcn_mfma_f32_16x16x32_bf16(Bt[n][k], At[m][k], acc[ai][bj][m][n], 0, 0, 0); __builtin_amdgcn_s_setprio(0); } while (0)
#define G_WAIT_V(n) asm volatile("s_waitcnt vmcnt(" #n ")" ::: "memory")
#define G_WAIT_L(n) asm volatile("s_waitcnt lgkmcnt(" #n ")" ::: "memory")
#define G_BAR __builtin_amdgcn_s_barrier()
#define G_SCHED __builtin_amdgcn_sched_barrier(0)
    Unit cur, nxt; int ui = 0;
    if (!S.next(0, cur)) return;
    f32x4 acc[2][2][4][2];
#pragma unroll
    for (int a = 0; a < 2; ++a)
#pragma unroll
        for (int b = 0; b < 2; ++b)
#pragma unroll
            for (int m = 0; m < 4; ++m)
#pragma unroll
                for (int n = 0; n < 2; ++n) acc[a][b][m][n] = (f32x4){0.f, 0.f, 0.f, 0.f};
    bf16x8 At[4][2], B0[2][2], B1[2][2];
    const char* cA0 = cur.a0; const char* cA1 = cur.a1; const char* cB = cur.b;
    G_STAGE_B(G_SB(0, 0), cB); G_STAGE_B(G_SB(0, 1), cB + hstepB); G_STAGE_A(G_SA(0, 0), cA0, cA1); G_STAGE_A(G_SA(0, 1), cA0 + hstepA, cA1 + hstepA);
    if (wr == 1) G_BAR;
    G_WAIT_V(2); G_BAR;
    G_STAGE_B(G_SB(1, 0), cB + kstepB); G_STAGE_A(G_SA(1, 0), cA0 + kstepA, cA1 + kstepA); G_STAGE_B(G_SB(1, 1), cB + hstepB + kstepB);
    G_WAIT_V(6); G_BAR;
    for (;;) {
        const bool has_next = S.next(ui + 1, nxt);
        const char* nA0 = has_next ? nxt.a0 : cA0; const char* nA1 = has_next ? nxt.a1 : cA1; const char* nB = has_next ? nxt.b : cB;
        for (int t = 0; t < nt; t += 2) {
            const bool last = (t == nt - 2);
            const char* a1_0 = cA0 + (size_t)(t + 1) * kstepA; const char* a1_1 = cA1 + (size_t)(t + 1) * kstepA;
            const char* a2_0 = last ? nA0 : cA0 + (size_t)(t + 2) * kstepA; const char* a2_1 = last ? nA1 : cA1 + (size_t)(t + 2) * kstepA;
            const char* b2 = last ? nB : cB + (size_t)(t + 2) * kstepB;
            const char* a3_0 = a2_0 + kstepA; const char* a3_1 = a2_1 + kstepA; const char* b3 = b2 + kstepB;
            G_LDB(B0, 0, 0); G_LDB(B1, 0, 1); G_SCHED; G_LDA(At, 0, 0); G_STAGE_A(G_SA(1, 1), a1_0 + hstepA, a1_1 + hstepA);
            G_WAIT_V(8); G_WAIT_L(0); G_BAR; G_MMA(0, 0, At, B0); G_MMA(0, 1, At, B1); G_BAR; G_SCHED;
            G_LDA(At, 0, 1); G_STAGE_B(G_SB(0, 0), b2); G_STAGE_B(G_SB(0, 1), b2 + hstepB); G_STAGE_A(G_SA(0, 0), a2_0, a2_1);
            G_WAIT_V(8); G_WAIT_L(0); G_BAR; G_MMA(1, 0, At, B0); G_MMA(1, 1, At, B1); G_BAR; G_SCHED;
            G_LDB(B0, 1, 0); G_LDB(B1, 1, 1); G_SCHED; G_LDA(At, 1, 0); G_STAGE_A(G_SA(0, 1), a2_0 + hstepA, a2_1 + hstepA);
            G_WAIT_V(8); G_WAIT_L(0); G_BAR; G_MMA(0, 0, At, B0); G_MMA(0, 1, At, B1); G_BAR; G_SCHED;
            G_LDA(At, 1, 1); G_STAGE_B(G_SB(1, 0), b3); G_STAGE_B(G_SB(1, 1), b3 + hstepB); G_STAGE_A(G_SA(1, 0), a3_0, a3_1);
            G_WAIT_V(8); G_WAIT_L(0); G_BAR; G_MMA(1, 0, At, B0); G_MMA(1, 1, At, B1); G_BAR; G_SCHED;
        }
        if (wr == 0) G_BAR;
        { int l_; asm volatile("v_mbcnt_lo_u32_b32 %0, -1, 0\n\tv_mbcnt_hi_u32_b32 %0, -1, %0" : "=v"(l_));
          E(acc, cur, wr, wc, l_ & 15, l_ >> 4); }
        if (!has_next) break;
#pragma unroll
        for (int a = 0; a < 2; ++a)
#pragma unroll
            for (int b = 0; b < 2; ++b)
#pragma unroll
                for (int m = 0; m < 4; ++m)
#pragma unroll
                    for (int n = 0; n < 2; ++n) acc[a][b][m][n] = (f32x4){0.f, 0.f, 0.f, 0.f};
        cur = nxt; cA0 = nA0; cA1 = nA1; cB = nB; ++ui;
        if (wr == 1) G_BAR;
    }
    G_WAIT_V(0);
    G_BAR;
#undef G_SA
#undef G_SB
#undef G_GLDS
#undef G_STAGE_A
#undef G_STAGE_B
#undef G_LDA
#undef G_LDB
#undef G_MMA
#undef G_WAIT_V
#undef G_WAIT_L
#undef G_BAR
#undef G_SCHED
}
namespace nk {
__device__ inline float gelu_tanh(float x) { const float u = 0.7978845608028654f * (x + 0.044715f * x * x * x); return 0.5f * x * (1.0f + tanhf(u)); }
__device__ inline float wave_sum(float v) { for (int o = 32; o >= 1; o >>= 1) v += __shfl_xor(v, o); return v; }

__global__ void nk_mods(const float* cp, const float* cs, const float* w_ada, const float* b_ada, float* mods) {
    __shared__ float cond[NB][D];
    for (int i = threadIdx.x; i < NB * D; i += 256) { const int b = i / D, k = i % D; const float c = b == 0 ? cp[k] : cs[(b - 1) * D + k]; cond[b][k] = c / (1.0f + expf(-c)); }
    __syncthreads();
    const int col = blockIdx.x * 256 + threadIdx.x, layer = col / 6144, n = col % 6144;
    float acc[NB];
    for (int b = 0; b < NB; ++b) acc[b] = 0.f;
    const float* w = w_ada + (size_t)layer * D * 6144 + n;
    for (int k = 0; k < D; ++k) { const float wv = w[(size_t)k * 6144]; for (int b = 0; b < NB; ++b) acc[b] += cond[b][k] * wv; }
    for (int b = 0; b < NB; ++b) mods[(size_t)(layer * NB + b) * 6144 + n] = acc[b] + b_ada[layer * 6144 + n];
}

__global__ void nk_ln_mod(const float* xp, const float* xs, const float* v, int use_ln, const float* lng, const float* lnb, const float* mods_l, int sh_off, int sc_off, float* H) {
    const int row = blockIdx.x * 4 + (threadIdx.x >> 6), lane = threadIdx.x & 63, b = tok_b(row);
    const float* src = use_ln ? v + (size_t)row * D : (row < NPROMPT ? xp + (size_t)row * D : xs + (size_t)(row - NPROMPT) * D);
    float4 x[4];
    for (int j = 0; j < 4; ++j) x[j] = *(const float4*)(src + j * 256 + lane * 4);
    if (use_ln) {
        float s = 0.f; for (int j = 0; j < 4; ++j) s += x[j].x + x[j].y + x[j].z + x[j].w;
        const float mean = wave_sum(s) * (1.0f / D);
        float q = 0.f; for (int j = 0; j < 4; ++j) { float d0 = x[j].x - mean, d1 = x[j].y - mean, d2 = x[j].z - mean, d3 = x[j].w - mean; q += d0 * d0 + d1 * d1 + d2 * d2 + d3 * d3; }
        const float rstd = rsqrtf(wave_sum(q) * (1.0f / D) + LN_EPS);
        for (int j = 0; j < 4; ++j) { const int n = j * 256 + lane * 4; const float4 g = *(const float4*)(lng + n), bb = *(const float4*)(lnb + n);
            x[j].x = (x[j].x - mean) * rstd * g.x + bb.x; x[j].y = (x[j].y - mean) * rstd * g.y + bb.y; x[j].z = (x[j].z - mean) * rstd * g.z + bb.z; x[j].w = (x[j].w - mean) * rstd * g.w + bb.w; }
    }
    const float* m = mods_l + (size_t)b * 6144;
    for (int j = 0; j < 4; ++j) { const int n = j * 256 + lane * 4; const float4 sc = *(const float4*)(m + sc_off * D + n), sh = *(const float4*)(m + sh_off * D + n);
        float4 o; o.x = x[j].x * (1.f + sc.x) + sh.x; o.y = x[j].y * (1.f + sc.y) + sh.y; o.z = x[j].z * (1.f + sc.z) + sh.z; o.w = x[j].w * (1.f + sc.w) + sh.w;
        *(float4*)(H + (size_t)row * D + n) = o; }
}

template <int ACT> __global__ void nk_gemm(const float* A, int lda, const float* W, int ldw, const float* bias, float* C, int ldc, int M, int N, int K) {
    __shared__ float As[16][68], Ws[16][64];
    const int tid = threadIdx.x, tx = tid & 15, ty = tid >> 4, m0 = blockIdx.y * 64, n0 = blockIdx.x * 64;
    float acc[4][4];
    for (int i = 0; i < 4; ++i) for (int j = 0; j < 4; ++j) acc[i][j] = 0.f;
    const int ar = tid >> 2, ak = (tid & 3) * 4; int arow = m0 + ar; if (arow >= M) arow = M - 1;
    const int wr = tid >> 4, wc = (tid & 15) * 4;
    for (int k0 = 0; k0 < K; k0 += 16) {
        float4 a = *(const float4*)(A + (size_t)arow * lda + k0 + ak);
        if (ACT == 1) { a.x = gelu_tanh(a.x); a.y = gelu_tanh(a.y); a.z = gelu_tanh(a.z); a.w = gelu_tanh(a.w); }
        const float4 w = *(const float4*)(W + (size_t)(k0 + wr) * ldw + n0 + wc);
        As[ak + 0][ar] = a.x; As[ak + 1][ar] = a.y; As[ak + 2][ar] = a.z; As[ak + 3][ar] = a.w;
        *(float4*)&Ws[wr][wc] = w;
        __syncthreads();
#pragma unroll
        for (int kk = 0; kk < 16; ++kk) { const float4 av = *(const float4*)&As[kk][ty * 4]; const float4 wv = *(const float4*)&Ws[kk][tx * 4];
            const float aa[4] = {av.x, av.y, av.z, av.w}, ww[4] = {wv.x, wv.y, wv.z, wv.w};
#pragma unroll
            for (int i = 0; i < 4; ++i)
#pragma unroll
                for (int j = 0; j < 4; ++j) acc[i][j] += aa[i] * ww[j]; }
        __syncthreads();
    }
    for (int i = 0; i < 4; ++i) { const int r = m0 + ty * 4 + i; if (r >= M) continue;
        float4 o; const int c = n0 + tx * 4; o.x = acc[i][0] + bias[c]; o.y = acc[i][1] + bias[c + 1]; o.z = acc[i][2] + bias[c + 2]; o.w = acc[i][3] + bias[c + 3];
        *(float4*)(C + (size_t)r * ldc + c) = o; }
}

__global__ void nk_dskip(const float* H, const float* d, float* Y) { const size_t i = (size_t)blockIdx.x * 256 + threadIdx.x; Y[i] = H[i] * d[i & (D - 1)]; }

__global__ void nk_s5_scan(const float* H, float* Y, int dir, const float* lam_re, const float* lam_im, const float* log_dt, const float* b_re, const float* b_im, const float* c_re, const float* c_im) {
    const int b = blockIdx.x / 64, g = blockIdx.x % 64, p = threadIdx.x;
    const int idx = (dir * 64 + g) * 64 + p;
    const double dt = exp((double)log_dt[dir * 64 + g]), lr = lam_re[idx], li = lam_im[idx];
    const double zr = lr * dt, zi = li * dt, mag = exp(zr), abr_d = mag * cos(zi), abi_d = mag * sin(zi);
    const double den = lr * lr + li * li, nr = abr_d - 1.0, ni = abi_d, fr = (nr * lr + ni * li) / den, fi = (ni * lr - nr * li) / den;
    float bbr[16], bbi[16], cr[16], ci[16];
    for (int h = 0; h < 16; ++h) { const double br = b_re[(size_t)idx * 16 + h], bi = b_im[(size_t)idx * 16 + h]; bbr[h] = (float)(fr * br - fi * bi); bbi[h] = (float)(fr * bi + fi * br);
        cr[h] = c_re[((size_t)(dir * 64 + g) * 16 + h) * 64 + p]; ci[h] = c_im[((size_t)(dir * 64 + g) * 16 + h) * 64 + p]; }
    const float abr = (float)abr_d, abi = (float)abi_d;
    const int s0 = seq_start(b), S = seq_len(b);
    float sr = 0.f, si = 0.f;
    for (int i = 0; i < S; ++i) {
        const int t = s0 + (dir == 0 ? i : S - 1 - i);
        const float* u = H + (size_t)t * D + g * 16;
        float bur = 0.f, bui = 0.f;
#pragma unroll
        for (int h = 0; h < 16; ++h) { const float uv = u[h]; bur += uv * bbr[h]; bui += uv * bbi[h]; }
        const float nsr = abr * sr - abi * si + bur, nsi = abr * si + abi * sr + bui; sr = nsr; si = nsi;
        float mine = 0.f;
#pragma unroll
        for (int h = 0; h < 16; ++h) { const float r = wave_sum(cr[h] * sr - ci[h] * si); if (p == h) mine = r; }
        if (p < 16) Y[(size_t)t * D + g * 16 + p] += mine;
    }
}

__global__ void nk_residual(const float* xp, const float* xs, float* vio, int use_ln, const float* lng, const float* lnb, const float* mods_l, int gate_off, const float* Ysrc, int glu, int row0, float* stats) {
    const int rc = blockIdx.x * 4 + (threadIdx.x >> 6), row = row0 + rc, lane = threadIdx.x & 63, b = tok_b(row);
    const float* src = use_ln ? vio + (size_t)row * D : (row < NPROMPT ? xp + (size_t)row * D : xs + (size_t)(row - NPROMPT) * D);
    float4 x[4];
    for (int j = 0; j < 4; ++j) x[j] = *(const float4*)(src + j * 256 + lane * 4);
    if (use_ln) {
        float s = 0.f; for (int j = 0; j < 4; ++j) s += x[j].x + x[j].y + x[j].z + x[j].w;
        const float mean = wave_sum(s) * (1.0f / D);
        float q = 0.f; for (int j = 0; j < 4; ++j) { float d0 = x[j].x - mean, d1 = x[j].y - mean, d2 = x[j].z - mean, d3 = x[j].w - mean; q += d0 * d0 + d1 * d1 + d2 * d2 + d3 * d3; }
        const float rstd = rsqrtf(wave_sum(q) * (1.0f / D) + LN_EPS);
        for (int j = 0; j < 4; ++j) { const int n = j * 256 + lane * 4; const float4 g = *(const float4*)(lng + n), bb = *(const float4*)(lnb + n);
            x[j].x = (x[j].x - mean) * rstd * g.x + bb.x; x[j].y = (x[j].y - mean) * rstd * g.y + bb.y; x[j].z = (x[j].z - mean) * rstd * g.z + bb.z; x[j].w = (x[j].w - mean) * rstd * g.w + bb.w; }
    }
    const float* gate = mods_l + (size_t)b * 6144 + gate_off * D;
    float s1 = 0.f, s2 = 0.f;
    for (int j = 0; j < 4; ++j) { const int n = j * 256 + lane * 4; float4 y;
        if (glu) { const float4 a = *(const float4*)(Ysrc + (size_t)rc * 2048 + n), g = *(const float4*)(Ysrc + (size_t)rc * 2048 + 1024 + n);
            y.x = a.x / (1.f + expf(-g.x)); y.y = a.y / (1.f + expf(-g.y)); y.z = a.z / (1.f + expf(-g.z)); y.w = a.w / (1.f + expf(-g.w)); }
        else y = *(const float4*)(Ysrc + (size_t)rc * D + n);
        const float4 gt = *(const float4*)(gate + n);
        float4 o; o.x = ALPHA * x[j].x + gt.x * y.x; o.y = ALPHA * x[j].y + gt.y * y.y; o.z = ALPHA * x[j].z + gt.z * y.z; o.w = ALPHA * x[j].w + gt.w * y.w;
        s1 += o.x + o.y + o.z + o.w; s2 += o.x * o.x + o.y * o.y + o.z * o.z + o.w * o.w;
        *(float4*)(vio + (size_t)row * D + n) = o; }
    s1 = wave_sum(s1); s2 = wave_sum(s2);
    if (lane == 0 && stats) { stats[row * 2] = s1; stats[row * 2 + 1] = s2; }
}

__global__ void nk_convgate(const float* UG, int ug0, int t0, int rows, const float* cw, const float* cb, float* Ac) {
    const size_t i = (size_t)blockIdx.x * 256 + threadIdx.x; if (i >= (size_t)rows * DFF) return;
    const int r = (int)(i / DFF), ch = (int)(i % DFF), t = t0 + r, b = tok_b(t), s0 = seq_start(b), s1 = s0 + seq_len(b);
    const float* u = UG + (size_t)(t - ug0) * (2 * DFF) + ch;
    const float up = (t - 1 >= s0) ? u[-(2 * DFF)] : 0.f, uc = u[0], un = (t + 1 < s1) ? u[2 * DFF] : 0.f;
    const float c = up * cw[ch] + uc * cw[DFF + ch] + un * cw[2 * DFF + ch] + cb[ch];
    Ac[(size_t)r * DFF + ch] = gelu_tanh(c) * u[DFF];
}

__global__ void nk_na_attn(const float* QKV, int kv0, int t0, const float* rpb, float* Oc) {
    const int wid = blockIdx.x * 4 + (threadIdx.x >> 6), lane = threadIdx.x & 63;
    const int r = wid >> 4, h = wid & 15, t = t0 + r, b = tok_b(t), s0 = seq_start(b), nrows = seq_len(b) / 64;
    const int tl = t - s0, gr = tl >> 6, gc = tl & 63;
    int rs = gr - 4; rs = rs < 0 ? 0 : (rs > nrows - 8 ? nrows - 8 : rs);
    int cs = gc - 8; cs = cs < 0 ? 0 : (cs > 48 ? 48 : cs);
    __shared__ float qs[4][64]; __shared__ float ps[4][128];
    const int w = threadIdx.x >> 6;
    qs[w][lane] = QKV[(size_t)(t - kv0) * 3072 + h * 64 + lane] * 0.125f;
    __syncthreads();
    float sc[2];
    for (int j = 0; j < 2; ++j) { const int kk = lane + j * 64, kr = rs + (kk >> 4), kc = cs + (kk & 15), kt = s0 + kr * 64 + kc;
        const float* kp = QKV + (size_t)(kt - kv0) * 3072 + 1024 + h * 64; float s = 0.f;
        for (int d = 0; d < 64; d += 4) { const float4 kv = *(const float4*)(kp + d); s += qs[w][d] * kv.x + qs[w][d + 1] * kv.y + qs[w][d + 2] * kv.z + qs[w][d + 3] * kv.w; }
        sc[j] = s + rpb[(h * 15 + (kr - gr + 7)) * 31 + (kc - gc + 15)]; }
    float m = fmaxf(sc[0], sc[1]); for (int o = 32; o >= 1; o >>= 1) m = fmaxf(m, __shfl_xor(m, o));
    const float e0 = expf(sc[0] - m), e1 = expf(sc[1] - m); const float sum = wave_sum(e0 + e1);
    ps[w][lane] = e0 / sum; ps[w][lane + 64] = e1 / sum;
    __syncthreads();
    float o = 0.f;
    for (int kk = 0; kk < 128; ++kk) { const int kr = rs + (kk >> 4), kc = cs + (kk & 15), kt = s0 + kr * 64 + kc; o += ps[w][kk] * QKV[(size_t)(kt - kv0) * 3072 + 2048 + h * 64 + lane]; }
    Oc[(size_t)r * D + h * 64 + lane] = o;
}

__global__ void nk_final_ln(float* v, const float* lng, const float* lnb) {
    const int row = blockIdx.x * 4 + (threadIdx.x >> 6), lane = threadIdx.x & 63;
    float4 x[4];
    for (int j = 0; j < 4; ++j) x[j] = *(const float4*)(v + (size_t)row * D + j * 256 + lane * 4);
    float s = 0.f; for (int j = 0; j < 4; ++j) s += x[j].x + x[j].y + x[j].z + x[j].w;
    const float mean = wave_sum(s) * (1.0f / D);
    float q = 0.f; for (int j = 0; j < 4; ++j) { float d0 = x[j].x - mean, d1 = x[j].y - mean, d2 = x[j].z - mean, d3 = x[j].w - mean; q += d0 * d0 + d1 * d1 + d2 * d2 + d3 * d3; }
    const float rstd = rsqrtf(wave_sum(q) * (1.0f / D) + LN_EPS);
    for (int j = 0; j < 4; ++j) { const int n = j * 256 + lane * 4; const float4 g = *(const float4*)(lng + n), bb = *(const float4*)(lnb + n);
        float4 o; o.x = (x[j].x - mean) * rstd * g.x + bb.x; o.y = (x[j].y - mean) * rstd * g.y + bb.y; o.z = (x[j].z - mean) * rstd * g.z + bb.z; o.w = (x[j].w - mean) * rstd * g.w + bb.w;
        *(float4*)(v + (size_t)row * D + n) = o; }
}

}
constexpr size_t KiB = 1024, MiB = 1024 * 1024;
constexpr size_t WS_CTL = 0;
constexpr size_t WS_MODS = 64 * KiB;
constexpr size_t WS_CVEC = 512 * KiB;
constexpr size_t WS_GAM = 1536 * KiB;
constexpr size_t WS_STATS = 2 * MiB;
constexpr size_t WS_PW = 4 * MiB;
constexpr size_t WS_BBAR = 9 * MiB;
constexpr size_t WS_KTAB = 10 * MiB;
constexpr size_t WS_WGLU = 18 * MiB;
constexpr size_t WS_WIN = 22 * MiB;
constexpr size_t WS_WOUT = 44 * MiB;
constexpr size_t WS_WQKV = 55 * MiB;
constexpr size_t WS_WO = 61 * MiB;
constexpr size_t WS_S = 64 * MiB;
constexpr size_t WS_YG = WS_S;
constexpr size_t WS_BSEND = WS_S;
constexpr size_t WS_SEND = WS_S + 32 * MiB;
constexpr size_t WS_AS5 = WS_S + 96 * MiB;
constexpr size_t WS_BS5 = WS_S + 216 * MiB;
constexpr size_t WS_APR = WS_S + 288 * MiB + 4096;
constexpr size_t WS_A0 = WS_S;
constexpr size_t WS_QKV = WS_S;
constexpr size_t WS_O = WS_S + 288 * MiB;
constexpr size_t WS_APR3 = WS_S + 4096;
constexpr size_t WS_A1 = WS_S + 100 * MiB;
constexpr size_t WS_NEED = WS_S + 386 * MiB;
constexpr int CV_IN0 = 0, CV_QKV = 2 * 9 * 5632, CV_IN1 = CV_QKV + 2 * 9 * 3072;

struct Params { const float* in[29]; float* out; unsigned char* ws; };
enum { I_XP = 0, I_XS, I_CP, I_CS, I_WADA, I_BADA, I_LNG, I_LNB, I_LRE, I_LIM, I_LDT, I_BRE, I_BIM, I_CRE, I_CIM, I_SD, I_WGLU, I_BGLU, I_WQKV, I_BQKV, I_RPB, I_WO, I_BO, I_WIN, I_BIN, I_CW, I_CB, I_WOUT, I_BOUT };

__device__ __forceinline__ const float* xin_row(const Params& p, int t) { return t < NPROMPT ? p.in[I_XP] + (size_t)t * D : p.in[I_XS] + (size_t)(t - NPROMPT) * D; }
__device__ __forceinline__ void row_stats(const float* st, int tok, float& mean, float& rstd) {
    const float2 s = *(const float2*)(st + (size_t)tok * 2); mean = s.x * (1.0f / D); const float var = s.y * (1.0f / D) - mean * mean; rstd = rsqrtf(fmaxf(var, 0.f) + LN_EPS); }

struct SchedPlain {
    TileOrder o; const char* A; const char* B; size_t a_rs, b_rs;
    __device__ bool next(int i, Unit& u) const { int pm, pn; if (!o.get(i, pm, pn)) return false;
        u.a0 = A + (size_t)(pm * 256) * a_rs; u.a1 = u.a0 + 128 * a_rs; u.b = B + (size_t)pn * 256 * b_rs; u.i0 = pm * 256; u.i1 = pn; return true; }
};
struct SchedS5 {
    TileOrder o; const char* A; const char* B; size_t b_gstride  , b_rs;
    __device__ bool next(int i, Unit& u) const { int pm, pn; if (!o.get(i, pm, pn)) return false; const int g = pm / 3;
        u.a0 = A + (size_t)(pm * 256) * 2560; u.a1 = u.a0 + (size_t)128 * 2560; u.b = B + (size_t)g * b_gstride + (size_t)pn * 256 * b_rs; u.i0 = pm * 256; u.i1 = pn; return true; }
};
__device__ __forceinline__ void ht_params(int ht, int& T, int& olo, int& ohi, int& s0, int& s1) {
    int b, jl;
    if (ht < 131) { b = 0; jl = ht; } else if (ht < 395) { b = 1 + (ht - 131) / 33; jl = (ht - 131) % 33; } else { T = 0; olo = 0; ohi = 0; s0 = 0; s1 = NPROMPT; return; }
    s0 = seq_start(b); s1 = s0 + seq_len(b); olo = s0 + 126 * jl; ohi = olo + 126 < s1 ? olo + 126 : s1; T = olo - 1;
}
constexpr int FFN_UNITS_M = 198;
struct SchedFfnIn {
    TileOrder o; const char* A; const char* B;
    __device__ bool next(int i, Unit& u) const { int pm, pn; if (!o.get(i, pm, pn)) return false; int T0, T1, a, b, c, d;
        ht_params(2 * pm, T0, a, b, c, d); ht_params(2 * pm + 1, T1, a, b, c, d);
        u.a0 = A + (long)T0 * 2048; u.a1 = A + (long)T1 * 2048; u.b = B + (size_t)pn * 256 * 2048; u.i0 = pm; u.i1 = pn; return true; }
};

typedef const f32x4 (&AccRef)[2][2][4][2];

struct EpiSend {
    float* C;
    __device__ __forceinline__ void operator()(AccRef acc, const Unit& u, int wr, int wc, int fr, int fq) const {
#pragma unroll
        for (int ai = 0; ai < 2; ++ai)
#pragma unroll
            for (int m = 0; m < 4; ++m) { float* p = C + (size_t)(u.i0 + 128 * wr + 64 * ai + 16 * m + fr) * 256 + 32 * wc + 8 * fq;
#pragma unroll
                for (int bj = 0; bj < 2; ++bj) { *(f32x4*)(p + 128 * bj) = acc[ai][bj][m][0]; *(f32x4*)(p + 128 * bj + 4) = acc[ai][bj][m][1]; } }
    }
};
struct EpiS5 {
    bf16_t* Y;
    __device__ __forceinline__ void operator()(AccRef acc, const Unit& u, int wr, int wc, int fr, int fq) const {
#pragma unroll
        for (int ai = 0; ai < 2; ++ai)
#pragma unroll
            for (int m = 0; m < 4; ++m) { bf16_t* p = Y + (size_t)(u.i0 + 128 * wr + 64 * ai + 16 * m + fr) * 1024 + u.i1 * 256 + 32 * wc + 8 * fq;
#pragma unroll
                for (int bj = 0; bj < 2; ++bj) { f32x4 v0 = acc[ai][bj][m][0], v1 = acc[ai][bj][m][1];
#pragma unroll
                    for (int j = 0; j < 4; ++j) { v0[j] = gelu_f(v0[j]); v1[j] = gelu_f(v1[j]); }
                    *(u32x4*)(p + 128 * bj) = pack8(v0, v1); }
                __builtin_amdgcn_sched_barrier(0); }
    }
};
struct EpiGlu {
    const float* xp; const float* xs; float* out; const float* bglu; const float* mods0; const float* gam; float* stats; bf16_t* apr;
    __device__ __forceinline__ void operator()(AccRef acc, const Unit& u, int wr, int wc, int fr, int fq) const {
        const int b = tok_b(u.i0), oc0 = 128 * u.i1 + 32 * wc + 8 * fq;
        f32x4 ba[2], bg[2], gm[2], ga[2];
#pragma unroll
        for (int n = 0; n < 2; ++n) { ba[n] = *(const f32x4*)(bglu + oc0 + 4 * n); bg[n] = *(const f32x4*)(bglu + 1024 + oc0 + 4 * n);
            gm[n] = *(const f32x4*)(mods0 + (size_t)b * 6144 + 2 * D + oc0 + 4 * n); ga[n] = *(const f32x4*)(gam + (size_t)b * D + oc0 + 4 * n); }
#pragma unroll
        for (int ai = 0; ai < 2; ++ai)
#pragma unroll
            for (int m = 0; m < 4; ++m) { const int tok = u.i0 + 128 * wr + 64 * ai + 16 * m + fr; const float* xr = (tok < NPROMPT ? xp + (size_t)tok * D : xs + (size_t)(tok - NPROMPT) * D) + oc0; float* vo = out + (size_t)tok * D + oc0;
                f32x4 v[2]; float s1 = 0.f, s2 = 0.f;
#pragma unroll
                for (int n = 0; n < 2; ++n) { const f32x4 x0 = *(const f32x4*)(xr + 4 * n); const f32x4 a = acc[ai][0][m][n] + ba[n], g = acc[ai][1][m][n] + bg[n];
#pragma unroll
                    for (int j = 0; j < 4; ++j) { const float gl = a[j] * sigmoid_f(g[j]); const float vv = ALPHA * x0[j] + gm[n][j] * gl; v[n][j] = vv; s1 += vv; s2 += vv * vv; }
                    *(f32x4*)(vo + 4 * n) = v[n]; }
                *(u32x4*)(apr + (size_t)tok * D + oc0) = pack8(v[0] * ga[0], v[1] * ga[1]);
                s1 += __shfl_xor(s1, 16); s2 += __shfl_xor(s2, 16); s1 += __shfl_xor(s1, 32); s2 += __shfl_xor(s2, 32);
                if (fq == 0) { atomic_add_f32(stats + (size_t)tok * 2, s1); atomic_add_f32(stats + (size_t)tok * 2 + 1, s2); } }
    }
};
struct EpiOut {
    float* vio; const float* bias; const float* lng; const float* lnb; const float* gate  ; const float* gam  ;
    const float* st_prev; float* st_next; bf16_t* apr;
    __device__ __forceinline__ void operator()(AccRef acc, const Unit& u, int wr, int wc, int fr, int fq) const {
        const int b = tok_b(u.i0);
        float s1[2][4], s2[2][4];
#pragma unroll
        for (int ai = 0; ai < 2; ++ai)
#pragma unroll
            for (int m = 0; m < 4; ++m) { s1[ai][m] = 0.f; s2[ai][m] = 0.f; }
#pragma unroll
        for (int bj = 0; bj < 2; ++bj) { const int oc0 = 256 * u.i1 + 128 * bj + 32 * wc + 8 * fq;
            f32x4 cp[2], cq[2], gt[2], ga[2];
#pragma unroll
            for (int n = 0; n < 2; ++n) { const f32x4 bi = *(const f32x4*)(bias + oc0 + 4 * n), lg = *(const f32x4*)(lng + oc0 + 4 * n), lb = *(const f32x4*)(lnb + oc0 + 4 * n);
                gt[n] = *(const f32x4*)(gate + (size_t)b * 6144 + oc0 + 4 * n); ga[n] = gam ? *(const f32x4*)(gam + (size_t)b * D + oc0 + 4 * n) : (f32x4){0.f, 0.f, 0.f, 0.f};
                cp[n] = lg * ALPHA; cq[n] = lb * ALPHA + gt[n] * bi; }
#pragma unroll
            for (int ai = 0; ai < 2; ++ai)
#pragma unroll
                for (int m = 0; m < 4; ++m) { const int tok = u.i0 + 128 * wr + 64 * ai + 16 * m + fr; float mean, rstd; row_stats(st_prev, tok, mean, rstd);
                    float* vp = (float*)((char*)vio + ((unsigned)tok * (unsigned)(D * 4) + (unsigned)oc0 * 4u)); f32x4 v[2];
#pragma unroll
                    for (int n = 0; n < 2; ++n) { const f32x4 vo = *(const f32x4*)(vp + 4 * n);
#pragma unroll
                        for (int j = 0; j < 4; ++j) { const float vv = rstd * cp[n][j] * (vo[j] - mean) + cq[n][j] + gt[n][j] * acc[ai][bj][m][n][j];
                            v[n][j] = vv; s1[ai][m] += vv; s2[ai][m] += vv * vv; }
                        *(f32x4*)(vp + 4 * n) = v[n]; }
                    if (apr) *(u32x4*)((char*)apr + ((unsigned)tok * (unsigned)(D * 2) + (unsigned)oc0 * 2u)) = pack8(v[0] * ga[0], v[1] * ga[1]); __builtin_amdgcn_sched_barrier(0); } }
#pragma unroll
        for (int ai = 0; ai < 2; ++ai)
#pragma unroll
            for (int m = 0; m < 4; ++m) { int fr2 = fr; asm volatile("" : "+v"(fr2)); const unsigned tok = (unsigned)(u.i0 + 128 * wr + 64 * ai + 16 * m + fr2); float a = s1[ai][m], q = s2[ai][m];
                a += __shfl_xor(a, 16); q += __shfl_xor(q, 16); a += __shfl_xor(a, 32); q += __shfl_xor(q, 32);
                if (st_next && fq == 0) { float* sp = (float*)((char*)st_next + tok * 8u); atomic_add_f32(sp, a); atomic_add_f32(sp + 1, q); } }
    }
};
struct EpiQkv {
    const float* c1; const float* c2; const float* st; bf16_t* O;
    __device__ __forceinline__ void operator()(AccRef acc, const Unit& u, int wr, int wc, int fr, int fq) const {
        const int b = tok_b(u.i0);
#pragma unroll
        for (int bj = 0; bj < 2; ++bj) { const int oc0 = 256 * u.i1 + 128 * bj + 32 * wc + 8 * fq; const float sc = oc0 < 1024 ? 0.125f : 1.0f;
            f32x4 k1[2], k2[2];
#pragma unroll
            for (int n = 0; n < 2; ++n) { k1[n] = *(const f32x4*)(c1 + (size_t)b * 3072 + oc0 + 4 * n); k2[n] = *(const f32x4*)(c2 + (size_t)b * 3072 + oc0 + 4 * n); }
#pragma unroll
            for (int ai = 0; ai < 2; ++ai)
#pragma unroll
                for (int m = 0; m < 4; ++m) { const int tok = u.i0 + 128 * wr + 64 * ai + 16 * m + fr; float mean, rstd; row_stats(st, tok, mean, rstd);
                    f32x4 v[2];
#pragma unroll
                    for (int n = 0; n < 2; ++n)
#pragma unroll
                        for (int j = 0; j < 4; ++j) v[n][j] = (rstd * (acc[ai][bj][m][n][j] - mean * k1[n][j]) + k2[n][j]) * sc;
                    *(u32x4*)(O + (size_t)tok * 3072 + oc0) = pack8(v[0], v[1]); __builtin_amdgcn_sched_barrier(0); } }
    }
};
__device__ __forceinline__ float dpp_prev(float cur, float prevgrp) {
    const int rot = __builtin_amdgcn_update_dpp(0, __float_as_int(prevgrp), 0x121  , 0xf, 0xf, false);
    return __int_as_float(__builtin_amdgcn_update_dpp(rot, __float_as_int(cur), 0x111  , 0xf, 0xf, false)); }
__device__ __forceinline__ float dpp_next(float cur, float nextgrp) {
    const int rot = __builtin_amdgcn_update_dpp(0, __float_as_int(nextgrp), 0x12F  , 0xf, 0xf, false);
    return __int_as_float(__builtin_amdgcn_update_dpp(rot, __float_as_int(cur), 0x101  , 0xf, 0xf, false)); }
struct EpiFfnIn {
    const float* c1; const float* c2;   const float* st; const float* cw; const float* cb; bf16_t* O;
    __device__ __forceinline__ void operator()(f32x4 (&acc)[2][2][4][2], const Unit& u, int wr, int wc, int fr, int fq) const {
        int T, olo, ohi, s0, s1; ht_params(2 * u.i0 + wr, T, olo, ohi, s0, s1);
        const int b = tok_b(s0), oc0 = 128 * u.i1 + 32 * wc + 8 * fq;
        {
            f32x4 k1u[2], k2u[2], k1g[2], k2g[2];
#pragma unroll
            for (int n = 0; n < 2; ++n) { k1u[n] = *(const f32x4*)(c1 + (size_t)b * 5632 + oc0 + 4 * n); k2u[n] = *(const f32x4*)(c2 + (size_t)b * 5632 + oc0 + 4 * n);
                k1g[n] = *(const f32x4*)(c1 + (size_t)b * 5632 + DFF + oc0 + 4 * n); k2g[n] = *(const f32x4*)(c2 + (size_t)b * 5632 + DFF + oc0 + 4 * n); }
#pragma unroll
            for (int ai = 0; ai < 2; ++ai)
#pragma unroll
                for (int m = 0; m < 4; ++m) { int tok = T + 64 * ai + 16 * m + fr; tok = tok < 0 ? 0 : (tok > NTOK - 1 ? NTOK - 1 : tok); float mean, rstd; row_stats(st, tok, mean, rstd);
#pragma unroll
                    for (int n = 0; n < 2; ++n)
#pragma unroll
                        for (int j = 0; j < 4; ++j) { acc[ai][0][m][n][j] = rstd * (acc[ai][0][m][n][j] - mean * k1u[n][j]) + k2u[n][j]; acc[ai][1][m][n][j] = rstd * (acc[ai][1][m][n][j] - mean * k1g[n][j]) + k2g[n][j]; } }
        }
        f32x4 w0[2], w1[2], w2[2], wb[2];
#pragma unroll
        for (int n = 0; n < 2; ++n) { w0[n] = *(const f32x4*)(cw + oc0 + 4 * n); w1[n] = *(const f32x4*)(cw + DFF + oc0 + 4 * n); w2[n] = *(const f32x4*)(cw + 2 * DFF + oc0 + 4 * n); wb[n] = *(const f32x4*)(cb + oc0 + 4 * n); }
#pragma unroll
        for (int gi = 0; gi < 8; ++gi) { const int ai = gi >> 2, m = gi & 3, gp = gi > 0 ? gi - 1 : 0, gn = gi < 7 ? gi + 1 : 7;
            const int tok = T + 64 * ai + 16 * m + fr; const bool pv = tok - 1 >= s0, nv = tok + 1 < s1, ov = tok >= olo && tok < ohi;
            f32x4 r[2];
#pragma unroll
            for (int n = 0; n < 2; ++n)
#pragma unroll
                for (int j = 0; j < 4; ++j) { const float uc = acc[ai][0][m][n][j];
                    float up = dpp_prev(uc, acc[gp >> 2][0][gp & 3][n][j]), un = dpp_next(uc, acc[gn >> 2][0][gn & 3][n][j]);
                    up = pv ? up : 0.f; un = nv ? un : 0.f;
                    const float c = w0[n][j] * up + w1[n][j] * uc + w2[n][j] * un + wb[n][j];
                    r[n][j] = gelu_f(c) * acc[ai][1][m][n][j]; }
            if (ov) *(u32x4*)((char*)O + ((unsigned)tok * (unsigned)(DFF * 2) + (unsigned)oc0 * 2u)) = pack8(r[0], r[1]); __builtin_amdgcn_sched_barrier(0); }
    }
};
__device__ __forceinline__ float2 cmul(float2 a, float2 b) { return make_float2(a.x * b.x - a.y * b.y, a.x * b.y + a.y * b.x); }

__device__ __forceinline__ void p0_mods(const Params& p, LAS unsigned char* lds, const int tid) {
    LAS float* cond = (LAS float*)lds; LAS float* red = (LAS float*)(lds + 36864);
    for (int i = tid; i < NB * D; i += NTHR) { const int b = i >> 10, k = i & 1023; const float c = b == 0 ? p.in[I_CP][k] : p.in[I_CS][(b - 1) * D + k]; cond[i] = c / (1.0f + expf(-c)); }
    __syncthreads();
    float* mods = (float*)(p.ws + WS_MODS);
    for (int item = blockIdx.x; item < 384; item += gridDim.x) {
        const int layer = item / 192, n0 = (item % 192) * 32, cl = tid & 31, ks = tid >> 5;
        const float* w = p.in[I_WADA] + (size_t)layer * D * 6144 + (size_t)(ks * 64) * 6144 + n0 + cl;
        float acc[NB];
#pragma unroll
        for (int b = 0; b < NB; ++b) acc[b] = 0.f;
        for (int k = 0; k < 64; ++k) { const float wv = w[(size_t)k * 6144];
#pragma unroll
            for (int b = 0; b < NB; ++b) acc[b] += cond[b * D + ks * 64 + k] * wv; }
#pragma unroll
        for (int b = 0; b < NB; ++b) red[(ks * 32 + cl) * NB + b] = acc[b];
        __syncthreads();
        if (tid < 288) { const int c2 = tid & 31, b = tid >> 5; float s = 0.f; for (int k2 = 0; k2 < 16; ++k2) s += red[(k2 * 32 + c2) * NB + b];
            mods[(size_t)(layer * NB + b) * 6144 + n0 + c2] = s + p.in[I_BADA][layer * 6144 + n0 + c2]; }
        __syncthreads();
    }
}
struct WDesc { const float* src; bf16_t* dst; int K, N, rows, kind, halfoff; };
__device__ __forceinline__ int wsrc_col(const WDesc& d, int np) { if (d.kind == 0) return col_of(np); const int tile = np >> 8, bj = (np >> 7) & 1, s = np & 127; return (bj ? d.halfoff : 0) + 128 * tile + col_of(s); }
__device__ __forceinline__ void p0_weights(const Params& p, LAS unsigned char* lds, const int tid) {
    LAS float* tile = (LAS float*)lds;
    WDesc ds[7];
    ds[0] = {p.in[I_WGLU], (bf16_t*)(p.ws + WS_WGLU), 1024, 2048, 2048, 1, 1024};
    ds[1] = {p.in[I_WIN], (bf16_t*)(p.ws + WS_WIN), 1024, 5632, 5632, 1, DFF};
    ds[2] = {p.in[I_WIN] + (size_t)1024 * 5632, (bf16_t*)(p.ws + WS_WIN) + (size_t)5632 * 1024, 1024, 5632, 5632, 1, DFF};
    ds[3] = {p.in[I_WOUT], (bf16_t*)(p.ws + WS_WOUT), DFF, 1024, 1024, 0, 0};
    ds[4] = {p.in[I_WOUT] + (size_t)DFF * 1024, (bf16_t*)(p.ws + WS_WOUT) + (size_t)1024 * DFF, DFF, 1024, 1024, 0, 0};
    ds[5] = {p.in[I_WQKV], (bf16_t*)(p.ws + WS_WQKV), 1024, 3072, 3072, 0, 0};
    ds[6] = {p.in[I_WO], (bf16_t*)(p.ws + WS_WO), 1024, 1024, 1024, 0, 0};
    int base = 0;
#pragma unroll
    for (int mi = 0; mi < 7; ++mi) { const WDesc d = ds[mi]; const int tk = d.K / 64, nt = (d.rows / 64) * tk;
        int first = (int)blockIdx.x - base % (int)gridDim.x; if (first < 0) first += gridDim.x;
        for (int it = first; it < nt; it += gridDim.x) { const int n0 = (it / tk) * 64, k0 = (it % tk) * 64;
            const int r = tid & 63; const int sc = wsrc_col(d, n0 + r);
#pragma unroll
            for (int j = 0; j < 8; ++j) { const int kk = (tid >> 6) + 8 * j; tile[r * 65 + kk] = d.src[(size_t)(k0 + kk) * d.N + sc]; }
            __syncthreads();
            { const int r2 = tid >> 3, kq = tid & 7; f32x4 a, b;
#pragma unroll
                for (int e = 0; e < 4; ++e) { a[e] = tile[r2 * 65 + kq * 8 + e]; b[e] = tile[r2 * 65 + kq * 8 + 4 + e]; }
                *(u32x4*)(d.dst + (size_t)(n0 + r2) * d.K + k0 + kq * 8) = pack8(a, b); }
            __syncthreads(); }
        base += nt; }
}
__device__ __forceinline__ void p0_s5tabs(const Params& p, const int tid) {
    const int gtid = blockIdx.x * NTHR + tid, gsz = gridDim.x * NTHR;
    float2* pw = (float2*)(p.ws + WS_PW); float2* bbar = (float2*)(p.ws + WS_BBAR);
    for (int i = gtid; i < 2 * 64 * 65 * 64; i += gsz) { const int pp = i & 63, tau = (i >> 6) % 65, dg = i / (64 * 65); const int idx = dg * 64 + pp;
        const double dt = exp((double)p.in[I_LDT][dg]), zr = (double)p.in[I_LRE][idx] * dt, zi = (double)p.in[I_LIM][idx] * dt; const double mag = exp(zr * tau), ang = zi * tau;
        pw[i] = make_float2((float)(mag * cos(ang)), (float)(mag * sin(ang))); }
    for (int i = gtid; i < 2 * 64 * 64 * 16; i += gsz) { const int idx = i >> 4, dg = idx >> 6;
        const double dt = exp((double)p.in[I_LDT][dg]), lr = p.in[I_LRE][idx], li = p.in[I_LIM][idx], zr = lr * dt, zi = li * dt, mag = exp(zr), abr = mag * cos(zi), abi = mag * sin(zi);
        const double den = lr * lr + li * li, nr = abr - 1.0, ni = abi, fr = (nr * lr + ni * li) / den, fi = (ni * lr - nr * li) / den; const double br = p.in[I_BRE][i], bi = p.in[I_BIM][i];
        bbar[i] = make_float2((float)(fr * br - fi * bi), (float)(fr * bi + fi * br)); }
    float* st = (float*)(p.ws + WS_STATS);
    for (int i = gtid; i < 4 * NTOK * 2; i += gsz) st[i] = 0.f;
}

__device__ __forceinline__ void p1_umat(const Params& p, LAS unsigned char* lds, const int tid) {
    const float* mods = (const float*)(p.ws + WS_MODS); bf16_t* As5 = (bf16_t*)(p.ws + WS_AS5);
    for (int tile = blockIdx.x; tile < NTOK / 16; tile += gridDim.x) { const int tok0 = tile * 16, b = tok_b(tok0); const float* m = mods + (size_t)b * 6144;
#pragma unroll
        for (int j = 0; j < 8; ++j) { const int tk = j * 2 + (tid >> 8), ch = (tid & 255) * 4; const f32x4 x = *(const f32x4*)(xin_row(p, tok0 + tk) + ch), sh = *(const f32x4*)(m + ch), sc = *(const f32x4*)(m + D + ch);
            f32x4 h; for (int e = 0; e < 4; ++e) h[e] = x[e] * (1.0f + sc[e]) + sh[e];
            u32x2 w; w.x = cvt_pk_bf16(h[0], h[1]); w.y = cvt_pk_bf16(h[2], h[3]); *(LAS u32x2*)(lds + (tk * 1024 + ch) * 2) = w; }
        __syncthreads();
        { const int g = tid >> 3, c = tile >> 2;
#pragma unroll
            for (int j = 0; j < 4; ++j) { const int q = (tid & 7) * 4 + j, tk = q >> 1, half = q & 1, s = (tile & 3) * 16 + tk;
                *(u32x4*)(As5 + ((size_t)(g * 768 + c) * 1280 + s * 16 + half * 8)) = *(const LAS u32x4*)(lds + (tk * 1024 + g * 16 + half * 8) * 2); } }
        __syncthreads(); }
}
__device__ __forceinline__ void p1_tables(const Params& p, const int tid) {
    const int gtid = blockIdx.x * NTHR + tid, gsz = gridDim.x * NTHR;
    const float2* pw = (const float2*)(p.ws + WS_PW); const float2* bbar = (const float2*)(p.ws + WS_BBAR); float* ktab = (float*)(p.ws + WS_KTAB);
    const float* cre = p.in[I_CRE]; const float* cim = p.in[I_CIM];
    for (int i = gtid; i < 2 * 64 * 64 * 256; i += gsz) { const int hp = i & 15, h = (i >> 4) & 15, tau = (i >> 8) & 63, dg = i >> 14; float s = 0.f;
        const float* cr = cre + (size_t)(dg * 16 + h) * 64; const float* ci = cim + (size_t)(dg * 16 + h) * 64; const float2* pwr = pw + (size_t)(dg * 65 + tau) * 64; const float2* bb = bbar + (size_t)dg * 64 * 16 + hp;
        for (int pp = 0; pp < 64; ++pp) { const float2 w = cmul(make_float2(cr[pp], ci[pp]), pwr[pp]); const float2 bv = bb[pp * 16]; s += w.x * bv.x - w.y * bv.y; }
        ktab[i] = s; }
    bf16_t* bsend = (bf16_t*)(p.ws + WS_BSEND);
    for (int i = gtid; i < 64 * 256 * 128; i += gsz) { const int oct = i & 127, np = (i >> 7) & 255, g = i >> 15, s = oct >> 1, half = oct & 1, col = col_of(np), seg = col >> 6, pp = col & 63, dir = seg >> 1, im = seg & 1;
        const float2 pv = pw[(size_t)((dir * 64 + g) * 65 + (dir == 0 ? 63 - s : s)) * 64 + pp]; const float2* bb = bbar + ((size_t)(dir * 64 + g) * 64 + pp) * 16 + half * 8; f32x4 a, b;
#pragma unroll
        for (int e = 0; e < 4; ++e) { const float2 x = cmul(pv, bb[e]), y = cmul(pv, bb[4 + e]); a[e] = im ? x.y : x.x; b[e] = im ? y.y : y.x; }
        *(u32x4*)(bsend + ((size_t)(g * 256 + np) * 1024 + s * 16 + half * 8)) = pack8(a, b); }
    bf16_t* bs5 = (bf16_t*)(p.ws + WS_BS5);
    for (int i = gtid; i < 64 * 1024 * 32; i += gsz) { const int oct = i & 31, np = (i >> 5) & 1023, g = i >> 15, col = col_of(np), t = col >> 4, h = col & 15, seg = oct >> 3, p0 = (oct & 7) * 8, dir = seg >> 1, im = seg & 1;
        const float* cr = cre + (size_t)((dir * 64 + g) * 16 + h) * 64 + p0; const float* ci = cim + (size_t)((dir * 64 + g) * 16 + h) * 64 + p0; const float2* pwr = pw + (size_t)((dir * 64 + g) * 65 + (dir == 0 ? t + 1 : 64 - t)) * 64 + p0; f32x4 a, b;
#pragma unroll
        for (int e = 0; e < 4; ++e) { const float2 x = cmul(make_float2(cr[e], ci[e]), pwr[e]), y = cmul(make_float2(cr[4 + e], ci[4 + e]), pwr[4 + e]); a[e] = im ? -x.y : x.x; b[e] = im ? -y.y : y.x; }
        *(u32x4*)(bs5 + ((size_t)(g * 1024 + np) * 1280 + 1024 + oct * 8)) = pack8(a, b); }
    const float* mods = (const float*)(p.ws + WS_MODS); float* gam = (float*)(p.ws + WS_GAM);
    for (int i = gtid; i < 3 * NB * D; i += gsz) { const int n = i & 1023, b = (i >> 10) % NB, j = i / (NB * D); const int layer = j == 0 ? 0 : 1, sco = j == 1 ? 1 : 4;
        gam[i] = p.in[I_LNG][j * D + n] * (1.0f + mods[(size_t)(layer * NB + b) * 6144 + sco * D + n]); }
}
__device__ __forceinline__ void p1_cvec(const Params& p, LAS unsigned char* lds, const int tid) {
    LAS float* gpr = (LAS float*)lds; LAS float* bpr = (LAS float*)(lds + 36864); LAS float* red = (LAS float*)(lds + 73728);
    const float* mods = (const float*)(p.ws + WS_MODS); float* cv = (float*)(p.ws + WS_CVEC);
    int last_sel = -1;
    for (int item = blockIdx.x; item < 448; item += gridDim.x) {
        const int sel = item < 176 ? 0 : (item < 272 ? 1 : 2), it = sel == 0 ? item : (sel == 1 ? item - 176 : item - 272);
        const int N = sel == 1 ? 3072 : 5632, layer = sel == 0 ? 0 : 1, lnj = sel, sco = sel == 1 ? 1 : 4, sho = sel == 1 ? 0 : 3;
        const float* W = sel == 0 ? p.in[I_WIN] : (sel == 1 ? p.in[I_WQKV] : p.in[I_WIN] + (size_t)1024 * 5632);
        const float* bias = sel == 0 ? p.in[I_BIN] : (sel == 1 ? p.in[I_BQKV] : p.in[I_BIN] + 5632);
        float* c1 = cv + (sel == 0 ? CV_IN0 : (sel == 1 ? CV_QKV : CV_IN1)); float* c2 = c1 + NB * N;
        if (sel != last_sel) { __syncthreads();
            for (int i = tid; i < NB * D; i += NTHR) { const int b = i >> 10, k = i & 1023; const float* m = mods + (size_t)(layer * NB + b) * 6144; const float sc = m[sco * D + k], sh = m[sho * D + k];
                gpr[i] = p.in[I_LNG][lnj * D + k] * (1.0f + sc); bpr[i] = p.in[I_LNB][lnj * D + k] * (1.0f + sc) + sh; }
            __syncthreads(); last_sel = sel; }
        const int n0 = it * 32, cl = tid & 31, ks = tid >> 5; const float* w = W + (size_t)(ks * 64) * N + n0 + cl;
        float a1[NB], a2[NB];
#pragma unroll
        for (int b = 0; b < NB; ++b) { a1[b] = 0.f; a2[b] = 0.f; }
        for (int k = 0; k < 64; ++k) { const float wv = w[(size_t)k * N];
#pragma unroll
            for (int b = 0; b < NB; ++b) { a1[b] += gpr[b * D + ks * 64 + k] * wv; a2[b] += bpr[b * D + ks * 64 + k] * wv; } }
#pragma unroll
        for (int b = 0; b < NB; ++b) { red[(ks * 32 + cl) * 18 + b] = a1[b]; red[(ks * 32 + cl) * 18 + 9 + b] = a2[b]; }
        __syncthreads();
        for (int o = tid; o < 576; o += NTHR) { const int c2i = o & 31, q = o >> 5; float s = 0.f; for (int k2 = 0; k2 < 16; ++k2) s += red[(k2 * 32 + c2i) * 18 + q];
            if (q < 9) c1[(size_t)q * N + n0 + c2i] = s; else c2[(size_t)(q - 9) * N + n0 + c2i] = s + bias[n0 + c2i]; }
        __syncthreads();
    }
}
__device__ __forceinline__ void p2_tbuild(const Params& p, const int tid) {
    const int gtid = blockIdx.x * NTHR + tid, gsz = gridDim.x * NTHR;
    const float* ktab = (const float*)(p.ws + WS_KTAB); bf16_t* bs5 = (bf16_t*)(p.ws + WS_BS5); const float* sd = p.in[I_SD];
    for (int i = gtid; i < 64 * 1024 * 128; i += gsz) { const int oct = i & 127, np = (i >> 7) & 1023, g = i >> 17, s = oct >> 1, half = oct & 1, col = col_of(np), t = col >> 4, h = col & 15;
        f32x4 a, b;
        if (t != s) { const int dir = t > s ? 0 : 1, tau = t > s ? t - s : s - t; const float* kp = ktab + ((size_t)((dir * 64 + g) * 64 + tau) * 256 + h * 16 + half * 8); a = *(const f32x4*)kp; b = *(const f32x4*)(kp + 4); }
        else { const float* kf = ktab + ((size_t)((0 * 64 + g) * 64) * 256 + h * 16 + half * 8); const float* kb = ktab + ((size_t)((1 * 64 + g) * 64) * 256 + h * 16 + half * 8);
            a = *(const f32x4*)kf + *(const f32x4*)kb; b = *(const f32x4*)(kf + 4) + *(const f32x4*)(kb + 4); const int dd = h - half * 8; const float dv = sd[g * 16 + h];
#pragma unroll
            for (int e = 0; e < 4; ++e) { if (dd == e) a[e] += dv; if (dd == 4 + e) b[e] += dv; } }
        *(u32x4*)(bs5 + ((size_t)(g * 1024 + np) * 1280 + s * 16 + half * 8)) = pack8(a, b); }
}
__device__ __forceinline__ void p3_carry(const Params& p, const int tid) {
    const int gtid = blockIdx.x * NTHR + tid, gsz = gridDim.x * NTHR;
    const float2* pw = (const float2*)(p.ws + WS_PW); const float* send = (const float*)(p.ws + WS_SEND); bf16_t* As5 = (bf16_t*)(p.ws + WS_AS5);
    for (int i = gtid; i < 2 * 64 * NB * 64; i += gsz) { const int pp = i & 63, rest = i >> 6, b = rest % NB, r2 = rest / NB, g = r2 & 63, dir = r2 >> 6;
        const float2 a64 = pw[(size_t)((dir * 64 + g) * 65 + 64) * 64 + pp]; const int c0 = seq_start(b) / 64, nch = seq_len(b) / 64;
        float2 car = make_float2(0.f, 0.f);
        for (int i0 = 0; i0 < nch; i0 += 8) { float2 sv[8];
#pragma unroll
            for (int e = 0; e < 8; ++e) { const int c = c0 + (dir == 0 ? i0 + e : nch - 1 - i0 - e); const float* sp = send + (size_t)(g * 768 + c) * 256 + dir * 128 + pp; sv[e] = make_float2(sp[0], sp[64]); }
#pragma unroll
            for (int e = 0; e < 8; ++e) { const int c = c0 + (dir == 0 ? i0 + e : nch - 1 - i0 - e); bf16_t* ap = As5 + (size_t)(g * 768 + c) * 1280 + 1024 + dir * 128 + pp; ap[0] = f2bf(car.x); ap[64] = f2bf(car.y);
                const float2 n = cmul(a64, car); car = make_float2(n.x + sv[e].x, n.y + sv[e].y); } } }
}
template <int OFF> __device__ __forceinline__ s16x4 tr_read(unsigned addr) { s16x4 r; asm volatile("ds_read_b64_tr_b16 %0, %1 offset:%2" : "=&v"(r) : "v"(addr), "i"(OFF) : "memory"); return r; }
constexpr int NA_K = 0, NA_V = 9 * 8192, NA_BIAS = 18 * 8192;
__device__ __forceinline__ void p9_attn(const Params& p, LAS unsigned char* lds, const int tid) {
    const int wid = tid >> 6, lane = tid & 63, l15 = lane & 15, g = lane >> 4, qr = wid >> 2, j = wid & 3;
    const bf16_t* qkv = (const bf16_t*)(p.ws + WS_QKV); bf16_t* o = (bf16_t*)(p.ws + WS_O);
    const int u0 = j == 0 ? 0 : (j == 1 ? 8 : (j == 2 ? 24 : 32));
    const int c = 16 * j + l15; int cs = c - 8; cs = cs < 0 ? 0 : (cs > 48 ? 48 : cs);
    LAS float* bias = (LAS float*)(lds + NA_BIAS);
    for (int item = blockIdx.x; item < 768; item += gridDim.x) {
        const int h = item & 15, rr = item >> 4; int b, R0; if (rr < 16) { b = 0; R0 = rr * 16; } else { b = 1 + ((rr - 16) >> 2); R0 = ((rr - 16) & 3) * 16; }
        const int s0 = seq_start(b), nrows = seq_len(b) / 64;
        __syncthreads();
        for (int i = tid; i < 465; i += NTHR) bias[i] = p.in[I_RPB][h * 465 + i];
        const bf16_t* kbase = qkv + 1024 + h * 64; const bf16_t* vbase = qkv + 2048 + h * 64;
        const int ltok = tid >> 3, lch = tid & 7; const unsigned lds_st = (unsigned)(ltok * 128 + ((lch ^ (ltok & 7)) * 16));
        int have_hi;
        {
            int lo = R0 - 4; lo = lo < 0 ? 0 : (lo > nrows - 8 ? nrows - 8 : lo); int hi = R0 + 1 - 4; hi = hi < 0 ? 0 : (hi > nrows - 8 ? nrows - 8 : hi); hi += 7;
            for (int kr = lo; kr <= hi; ++kr) { const size_t tk = (size_t)(s0 + kr * 64 + ltok) * 3072 + lch * 8; const u32x4 kv = *(const u32x4*)(kbase + tk), vv = *(const u32x4*)(vbase + tk);
                const unsigned so = (unsigned)((kr % 9) * 8192) + lds_st; *(LAS u32x4*)(lds + NA_K + so) = kv; *(LAS u32x4*)(lds + NA_V + so) = vv; }
            have_hi = hi; }
        __syncthreads();
        for (int pp = 0; pp < 8; ++pp) {
            const int r0 = R0 + 2 * pp;
            u32x4 nk[2], nv[2]; int nnew = 0, nlo = 0;
            if (pp < 7) { int hi = r0 + 3 - 4; hi = hi < 0 ? 0 : (hi > nrows - 8 ? nrows - 8 : hi); hi += 7; nlo = have_hi + 1; nnew = hi - have_hi;
#pragma unroll
                for (int e = 0; e < 2; ++e) if (e < nnew) { const size_t tk = (size_t)(s0 + (nlo + e) * 64 + ltok) * 3072 + lch * 8; nk[e] = *(const u32x4*)(kbase + tk); nv[e] = *(const u32x4*)(vbase + tk); } }
            const int r = r0 + qr; int rs = r - 4; rs = rs < 0 ? 0 : (rs > nrows - 8 ? nrows - 8 : rs);
            const size_t tq = (size_t)(s0 + r * 64 + c);
            bf16x8 qf[2]; qf[0] = *(const bf16x8*)(qkv + tq * 3072 + h * 64 + g * 8); qf[1] = *(const bf16x8*)(qkv + tq * 3072 + h * 64 + 32 + g * 8);
            f32x4 S[8][2];
#pragma unroll
            for (int k8 = 0; k8 < 8; ++k8) { const unsigned slot = (unsigned)(((rs + k8) % 9) * 8192);
#pragma unroll
                for (int tl = 0; tl < 2; ++tl) { const int col = u0 + 16 * tl + l15; f32x4 a = (f32x4){0.f, 0.f, 0.f, 0.f};
#pragma unroll
                    for (int ks = 0; ks < 2; ++ks) { const bf16x8 kf = *(const LAS bf16x8*)(lds + NA_K + slot + col * 128 + (((g + 4 * ks) ^ (col & 7)) * 16)); a = __builtin_amdgcn_mfma_f32_16x16x32_bf16(kf, qf[ks], a, 0, 0, 0); }
                    S[k8][tl] = a; } }
            float mx = -3.0e38f;
#pragma unroll
            for (int k8 = 0; k8 < 8; ++k8)
#pragma unroll
                for (int tl = 0; tl < 2; ++tl)
#pragma unroll
                    for (int e = 0; e < 4; ++e) { const int kc = u0 + 16 * tl + 4 * g + e; const bool ok = kc >= cs && kc <= cs + 15; int bi = (rs + k8 - r + 7) * 31 + (kc - c + 15); bi = ok ? bi : 0;
                        const float sv = ok ? S[k8][tl][e] + bias[bi] : -3.0e38f; S[k8][tl][e] = sv; mx = fmaxf(mx, sv); }
            mx = fmaxf(mx, __shfl_xor(mx, 16)); mx = fmaxf(mx, __shfl_xor(mx, 32));
            float sum = 0.f;
#pragma unroll
            for (int k8 = 0; k8 < 8; ++k8)
#pragma unroll
                for (int tl = 0; tl < 2; ++tl)
#pragma unroll
                    for (int e = 0; e < 4; ++e) { const float pe = __expf(S[k8][tl][e] - mx); S[k8][tl][e] = pe; sum += pe; }
            sum += __shfl_xor(sum, 16); sum += __shfl_xor(sum, 32);
            const float inv = 1.0f / sum;
            f32x4 O[4];
#pragma unroll
            for (int dt = 0; dt < 4; ++dt) O[dt] = (f32x4){0.f, 0.f, 0.f, 0.f};
#pragma unroll
            for (int k8 = 0; k8 < 8; ++k8) { const unsigned slot = (unsigned)(((rs + k8) % 9) * 8192);
                const u32x4 pk = pack8(S[k8][0] * inv, S[k8][1] * inv); bf16x8 pf; __builtin_memcpy(&pf, &pk, 16);
                const int col0 = u0 + 4 * g + (l15 >> 2), col1 = col0 + 16;
#pragma unroll
                for (int dt = 0; dt < 4; ++dt) { const int ch = dt * 2 + ((l15 & 3) >> 1);
                    const unsigned a0 = (unsigned)(NA_V) + slot + (unsigned)(col0 * 128 + ((ch ^ (col0 & 7)) * 16) + (l15 & 1) * 8), a1 = (unsigned)(NA_V) + slot + (unsigned)(col1 * 128 + ((ch ^ (col1 & 7)) * 16) + (l15 & 1) * 8);
                    const s16x4 v0 = tr_read<0>(a0), v1 = tr_read<0>(a1);
                    asm volatile("s_waitcnt lgkmcnt(0)" ::: "memory"); __builtin_amdgcn_sched_barrier(0);
                    const bf16x8 vf = (bf16x8){v0[0], v0[1], v0[2], v0[3], v1[0], v1[1], v1[2], v1[3]};
                    O[dt] = __builtin_amdgcn_mfma_f32_16x16x32_bf16(vf, pf, O[dt], 0, 0, 0); } }
#pragma unroll
            for (int dt = 0; dt < 4; ++dt) { u32x2 w; w.x = cvt_pk_bf16(O[dt][0], O[dt][1]); w.y = cvt_pk_bf16(O[dt][2], O[dt][3]); *(u32x2*)(o + tq * D + h * 64 + dt * 16 + 4 * g) = w; }
            __syncthreads();
#pragma unroll
            for (int e = 0; e < 2; ++e) if (e < nnew) { const unsigned so = (unsigned)(((nlo + e) % 9) * 8192) + lds_st; *(LAS u32x4*)(lds + NA_K + so) = nk[e]; *(LAS u32x4*)(lds + NA_V + so) = nv[e]; }
            have_hi += nnew;
            __syncthreads();
        }
    }
}
__device__ __forceinline__ void p13_final(const Params& p, const int tid) {
    const int wv = blockIdx.x * (NTHR / 64) + (tid >> 6), nwv = gridDim.x * (NTHR / 64), lane = tid & 63;
    const float* lng = p.in[I_LNG] + 3 * D; const float* lnb = p.in[I_LNB] + 3 * D;
    for (int row = wv; row < NTOK; row += nwv) { float* v = p.out + (size_t)row * D; f32x4 x[4];
#pragma unroll
        for (int q = 0; q < 4; ++q) x[q] = *(const f32x4*)(v + q * 256 + lane * 4);
        float s = 0.f;
#pragma unroll
        for (int q = 0; q < 4; ++q) s += (x[q][0] + x[q][1]) + (x[q][2] + x[q][3]);
        for (int o = 32; o >= 1; o >>= 1) s += __shfl_xor(s, o);
        const float mean = s * (1.0f / D); float q2 = 0.f;
#pragma unroll
        for (int q = 0; q < 4; ++q) { const f32x4 d = x[q] - mean; q2 += (d[0] * d[0] + d[1] * d[1]) + (d[2] * d[2] + d[3] * d[3]); }
        for (int o = 32; o >= 1; o >>= 1) q2 += __shfl_xor(q2, o);
        const float rstd = rsqrtf(q2 * (1.0f / D) + LN_EPS);
#pragma unroll
        for (int q = 0; q < 4; ++q) { const int n = q * 256 + lane * 4; const f32x4 gg = *(const f32x4*)(lng + n), bb = *(const f32x4*)(lnb + n); *(f32x4*)(v + n) = (x[q] - mean) * rstd * gg + bb; } }
}
__device__ __forceinline__ void ph_gemm_send(const Params& p, LAS unsigned char* lds, const int tid) {
    SchedS5 S; S.o.init(192, 1, gridDim.x, blockIdx.x); S.A = (const char*)(p.ws + WS_AS5); S.B = (const char*)(p.ws + WS_BSEND); S.b_gstride = (size_t)256 * 2048; S.b_rs = 2048;
    const GShape g{16, 2560u, 32u, 2048u}; const EpiSend E{(float*)(p.ws + WS_SEND)};
    gemm_phase(lds, g, S, E, tid);
}
__device__ __forceinline__ void ph_gemm_s5(const Params& p, LAS unsigned char* lds, const int tid) {
    SchedS5 S; S.o.init(192, 4, gridDim.x, blockIdx.x); S.A = (const char*)(p.ws + WS_AS5); S.B = (const char*)(p.ws + WS_BS5); S.b_gstride = (size_t)1024 * 2560; S.b_rs = 2560;
    const GShape g{20, 2560u, 32u, 2560u}; const EpiS5 E{(bf16_t*)(p.ws + WS_YG)};
    gemm_phase(lds, g, S, E, tid);
}
__device__ __forceinline__ void ph_gemm_glu(const Params& p, LAS unsigned char* lds, const int tid) {
    SchedPlain S; S.o.init(192, 8, gridDim.x, blockIdx.x); S.A = (const char*)(p.ws + WS_YG); S.B = (const char*)(p.ws + WS_WGLU); S.a_rs = 32; S.b_rs = 2048;
    const GShape g{16, 32u, (unsigned)(NTOK * 32), 2048u};
    const EpiGlu E{p.in[I_XP], p.in[I_XS], p.out, p.in[I_BGLU], (const float*)(p.ws + WS_MODS), (const float*)(p.ws + WS_GAM), (float*)(p.ws + WS_STATS), (bf16_t*)(p.ws + WS_APR)};
    gemm_phase(lds, g, S, E, tid);
}
__device__ __forceinline__ void ph_gemm_ffn_in(const Params& p, LAS unsigned char* lds, const int tid, int layer) {
    SchedFfnIn S; S.o.init(FFN_UNITS_M, 22, gridDim.x, blockIdx.x); S.A = (const char*)(p.ws + (layer == 0 ? WS_APR : WS_APR3)); S.B = (const char*)(p.ws + WS_WIN) + (size_t)layer * 5632 * 2048;
    const GShape g{16, 2048u, 32u, 2048u};
    const float* c1 = (const float*)(p.ws + WS_CVEC) + (layer == 0 ? CV_IN0 : CV_IN1);
    const EpiFfnIn E{c1, c1 + NB * 5632, (const float*)(p.ws + WS_STATS) + (size_t)(layer == 0 ? 0 : 2) * NTOK * 2, p.in[I_CW] + (size_t)layer * 3 * DFF, p.in[I_CB] + (size_t)layer * DFF, (bf16_t*)(p.ws + (layer == 0 ? WS_A0 : WS_A1))};
    gemm_phase(lds, g, S, E, tid);
}
__device__ __forceinline__ void ph_gemm_ffn_out(const Params& p, LAS unsigned char* lds, const int tid, int layer) {
    SchedPlain S; S.o.init(192, 4, gridDim.x, blockIdx.x); S.A = (const char*)(p.ws + (layer == 0 ? WS_A0 : WS_A1)); S.B = (const char*)(p.ws + WS_WOUT) + (size_t)layer * 1024 * 5632; S.a_rs = 5632; S.b_rs = 5632;
    const GShape g{44, 5632u, 32u, 5632u};
    const float* mods_l = (const float*)(p.ws + WS_MODS) + (size_t)layer * NB * 6144; float* st = (float*)(p.ws + WS_STATS);
    const EpiOut E{p.out, p.in[I_BOUT] + layer * D, p.in[I_LNG] + (layer * 2) * D, p.in[I_LNB] + (layer * 2) * D, mods_l + 5 * D, layer == 0 ? (const float*)(p.ws + WS_GAM) + NB * D : nullptr,
                   st + (size_t)(layer == 0 ? 0 : 2) * NTOK * 2, layer == 0 ? st + (size_t)1 * NTOK * 2 : nullptr, layer == 0 ? (bf16_t*)(p.ws + WS_APR) : nullptr};
    gemm_phase(lds, g, S, E, tid);
}
__device__ __forceinline__ void ph_gemm_qkv(const Params& p, LAS unsigned char* lds, const int tid) {
    SchedPlain S; S.o.init(192, 12, gridDim.x, blockIdx.x); S.A = (const char*)(p.ws + WS_APR); S.B = (const char*)(p.ws + WS_WQKV); S.a_rs = 2048; S.b_rs = 2048;
    const GShape g{16, 2048u, 32u, 2048u}; const float* c1 = (const float*)(p.ws + WS_CVEC) + CV_QKV;
    const EpiQkv E{c1, c1 + NB * 3072, (const float*)(p.ws + WS_STATS) + (size_t)1 * NTOK * 2, (bf16_t*)(p.ws + WS_QKV)};
    gemm_phase(lds, g, S, E, tid);
}
__device__ __forceinline__ void ph_gemm_wo(const Params& p, LAS unsigned char* lds, const int tid) {
    SchedPlain S; S.o.init(192, 4, gridDim.x, blockIdx.x); S.A = (const char*)(p.ws + WS_O); S.B = (const char*)(p.ws + WS_WO); S.a_rs = 2048; S.b_rs = 2048;
    const GShape g{16, 2048u, 32u, 2048u};
    const float* mods_l = (const float*)(p.ws + WS_MODS) + (size_t)1 * NB * 6144; float* st = (float*)(p.ws + WS_STATS);
    const EpiOut E{p.out, p.in[I_BO], p.in[I_LNG] + 1 * D, p.in[I_LNB] + 1 * D, mods_l + 2 * D, (const float*)(p.ws + WS_GAM) + 2 * NB * D, st + (size_t)1 * NTOK * 2, st + (size_t)2 * NTOK * 2, (bf16_t*)(p.ws + WS_APR3)};
    gemm_phase(lds, g, S, E, tid);
}

#define XB_TMO      128
#define XB_XCNT(j)  (256  + 64 * (j))
#define XB_XSUB(j)  (1280 + 64 * (j))
#define XB_XGEN(j)  (2304 + 64 * (j))
#define XB_TOP      3328
#define XB_TOPGEN   3392
#define XCD_BAR_WORDS 3456
#define XB_SPIN_CAP (1u << 18)
__device__ __forceinline__ unsigned xb_ld(unsigned* p)              { return __hip_atomic_load(p, __ATOMIC_RELAXED, __HIP_MEMORY_SCOPE_AGENT); }
__device__ __forceinline__ unsigned xb_add(unsigned* p, unsigned v) { return __hip_atomic_fetch_add(p, v, __ATOMIC_RELAXED, __HIP_MEMORY_SCOPE_AGENT); }
__device__ __forceinline__ unsigned xb_xcc_id() { return (unsigned)__builtin_amdgcn_s_getreg((3 << 11) | 20) & 0xFu; }
#define XB_SPIN(cond, bar) do { unsigned _sp = 0; while (cond) { __builtin_amdgcn_s_sleep(1); \
    if ((++_sp & 255u) == 0u) { if (xb_ld(&(bar)[XB_TMO])) break; if (_sp > XB_SPIN_CAP) { atomicAdd(&(bar)[XB_TMO], 1u); break; } } } } while (0)
struct XcdBarrier { unsigned* bar; unsigned x; volatile LAS unsigned* st; int wid0; };
__device__ __forceinline__ XcdBarrier xcd_barrier_post(unsigned* bar, volatile LAS unsigned* st, const int wid0) {
    XcdBarrier b; b.bar = bar; b.x = xb_xcc_id(); b.st = st; b.wid0 = wid0;
    if (wid0 == 0 && lane_id_asm() == 0) (void)xb_add(&bar[XB_XCNT(b.x)], 1u);
    return b;
}
__device__ __forceinline__ void xcd_barrier_complete(unsigned* bar, unsigned x, unsigned& nloc, unsigned& nx) {
    const unsigned G = gridDim.x * gridDim.y * gridDim.z;
    unsigned sum, cnt, mine, sp = 0u;
    for (;;) {
        sum = 0u; cnt = 0u; mine = 0u;
#pragma unroll
        for (unsigned j = 0; j < 16; ++j) { const unsigned c = xb_ld(&bar[XB_XCNT(j)]); sum += c; cnt += (c > 0u) ? 1u : 0u; mine = (j == x) ? c : mine; }
        if (sum == G) break;
        __builtin_amdgcn_s_sleep(1);
        if ((++sp & 255u) == 0u) { if (xb_ld(&bar[XB_TMO])) break; if (sp > XB_SPIN_CAP) { atomicAdd(&bar[XB_TMO], 1u); break; } }
    }
    nloc = mine > 0u ? mine : 1u; nx = cnt > 0u ? cnt : 1u;
}
__device__ __forceinline__ void xcd_barrier(const XcdBarrier& b) {
    asm volatile("s_waitcnt vmcnt(0)" ::: "memory");
    __syncthreads();
    if (b.wid0 == 0 && lane_id_asm() == 0) {
        unsigned* bar = b.bar;
        __builtin_amdgcn_s_waitcnt(0);
        unsigned nloc = b.st[0], nx = b.st[1];
        if (nloc == 0u) { xcd_barrier_complete(bar, b.x, nloc, nx); b.st[0] = nloc; b.st[1] = nx; }
        const unsigned old = xb_add(&bar[XB_XSUB(b.x)], 1u);
        const unsigned gen = old / nloc;
        if (old + 1u == (gen + 1u) * nloc) {
            __builtin_amdgcn_fence(__ATOMIC_RELEASE, "agent");
            asm volatile("s_waitcnt vmcnt(0)" ::: "memory");
            const unsigned og = xb_add(&bar[XB_TOP], 1u);
            const unsigned tg = og / nx;
            if (og + 1u == (tg + 1u) * nx) xb_add(&bar[XB_TOPGEN], 1u);
            else XB_SPIN(xb_ld(&bar[XB_TOPGEN]) == tg, bar);
            __builtin_amdgcn_fence(__ATOMIC_ACQUIRE, "agent");
            xb_add(&bar[XB_XGEN(b.x)], 1u);
            asm volatile("s_waitcnt vmcnt(0)" ::: "memory");
        } else {
            XB_SPIN(xb_ld(&bar[XB_XGEN(b.x)]) == gen, bar);
            __builtin_amdgcn_fence(__ATOMIC_ACQUIRE, "agent");
            asm volatile("s_waitcnt vmcnt(0)" ::: "memory");
        }
    }
    __syncthreads();
}

constexpr int LDS_BYTES = 152 * 1024, LDS_MISC = 150 * 1024;
constexpr int N_PHASES = 14;
__global__ void __launch_bounds__(NTHR, 2) k_fwd(Params p, int lo, int hi) {
    extern __shared__ __attribute__((aligned(16))) unsigned char lds_raw[];
    LAS unsigned char* lds = (LAS unsigned char*)lds_raw;
    volatile LAS unsigned* misc = (volatile LAS unsigned*)(lds + LDS_MISC);
    const int wid0 = __builtin_amdgcn_readfirstlane((int)threadIdx.x >> 6);
    if (threadIdx.x < 4) misc[threadIdx.x] = 0u;
    __syncthreads();
    XcdBarrier bar; bar.bar = (unsigned*)(p.ws + WS_CTL); bar.x = 0; bar.st = misc; bar.wid0 = wid0;
    const bool multi = (hi - lo) > 1;
    if (multi) bar = xcd_barrier_post((unsigned*)(p.ws + WS_CTL), misc, wid0);
#define PH(k) (lo <= (k) && (k) < hi)
#define SEAM(k) do { if (PH(k) && PH((k) + 1)) { if ((k) == 0) cg::this_grid().sync(); else xcd_barrier(bar); } } while (0)
#define TID (wid0 * 64 + lane_id_asm())
    if (PH(0)) { const int tid = TID; p0_mods(p, lds, tid); __syncthreads(); p0_weights(p, lds, tid); p0_s5tabs(p, tid); } SEAM(0);
    if (PH(1)) { const int tid = TID; p1_umat(p, lds, tid); p1_tables(p, tid); __syncthreads(); p1_cvec(p, lds, tid); } SEAM(1);
    if (PH(2)) { const int tid = TID; ph_gemm_send(p, lds, tid); p2_tbuild(p, tid); } SEAM(2);
    if (PH(3)) { p3_carry(p, TID); } SEAM(3);
    if (PH(4)) { ph_gemm_s5(p, lds, TID); } SEAM(4);
    if (PH(5)) { ph_gemm_glu(p, lds, TID); } SEAM(5);
    if (PH(6)) { ph_gemm_ffn_in(p, lds, TID, 0); } SEAM(6);
    if (PH(7)) { ph_gemm_ffn_out(p, lds, TID, 0); } SEAM(7);
    if (PH(8)) { ph_gemm_qkv(p, lds, TID); } SEAM(8);
    if (PH(9)) { p9_attn(p, lds, TID); } SEAM(9);
    if (PH(10)) { ph_gemm_wo(p, lds, TID); } SEAM(10);
    if (PH(11)) { ph_gemm_ffn_in(p, lds, TID, 1); } SEAM(11);
    if (PH(12)) { ph_gemm_ffn_out(p, lds, TID, 1); } SEAM(12);
    if (PH(13)) { p13_final(p, TID); }
#undef TID
#undef PH
#undef SEAM
}
#ifndef MK_NOPT
#define MK_NOPT 5
#endif
#ifndef MK_ONE
#define MK_ONE 1
#endif
static void naive_tail(int first_stage, void* const* d_in, float* out, char* ws, hipStream_t stream) {
    using namespace nk;
    const float* xp = (const float*)d_in[0]; const float* xs = (const float*)d_in[1]; const float* cp = (const float*)d_in[2]; const float* cs = (const float*)d_in[3];
    const float* w_ada = (const float*)d_in[4]; const float* b_ada = (const float*)d_in[5]; const float* ln_g = (const float*)d_in[6]; const float* ln_b = (const float*)d_in[7];
    const float* lam_re = (const float*)d_in[8]; const float* lam_im = (const float*)d_in[9]; const float* log_dt = (const float*)d_in[10];
    const float* b_re = (const float*)d_in[11]; const float* b_im = (const float*)d_in[12]; const float* c_re = (const float*)d_in[13]; const float* c_im = (const float*)d_in[14];
    const float* s5_d = (const float*)d_in[15]; const float* w_glu = (const float*)d_in[16]; const float* b_glu = (const float*)d_in[17];
    const float* w_qkv = (const float*)d_in[18]; const float* b_qkv = (const float*)d_in[19]; const float* rpb = (const float*)d_in[20]; const float* w_o = (const float*)d_in[21]; const float* b_o = (const float*)d_in[22];
    const float* w_in = (const float*)d_in[23]; const float* b_in = (const float*)d_in[24]; const float* conv_w = (const float*)d_in[25]; const float* conv_b = (const float*)d_in[26];
    const float* w_out = (const float*)d_in[27]; const float* b_out = (const float*)d_in[28];
    const size_t MB = 1ull << 20;
    float* H = (float*)(ws); float* R1 = (float*)(ws + 192 * MB); float* mods = (float*)(ws + 400 * MB);
    const int CH = 4096;
    if (first_stage > 4) return;
    nk_mods<<<48, 256, 0, stream>>>(cp, cs, w_ada, b_ada, mods);
    if (first_stage <= 0) {
        nk_ln_mod<<<NTOK / 4, 256, 0, stream>>>(xp, xs, nullptr, 0, nullptr, nullptr, mods, 0, 1, H);
        float* Y = R1;
        nk_dskip<<<NTOK * D / 256, 256, 0, stream>>>(H, s5_d, Y);
        nk_s5_scan<<<NB * 64, 64, 0, stream>>>(H, Y, 0, lam_re, lam_im, log_dt, b_re, b_im, c_re, c_im);
        nk_s5_scan<<<NB * 64, 64, 0, stream>>>(H, Y, 1, lam_re, lam_im, log_dt, b_re, b_im, c_re, c_im);
        for (int c0 = 0; c0 < NTOK; c0 += CH) { float* AG = H;
            nk_gemm<1><<<dim3(2048 / 64, CH / 64), 256, 0, stream>>>(Y + (size_t)c0 * D, D, w_glu, 2048, b_glu, AG, 2048, CH, 2048, D);
            nk_residual<<<CH / 4, 256, 0, stream>>>(xp, xs, out, 0, nullptr, nullptr, mods, 2, AG, 1, c0, nullptr); }
    }
    for (int layer = 0; layer < 2; ++layer) {
        const float* mods_l = mods + (size_t)layer * NB * 6144;
        if (layer == 1 && first_stage <= 2) {
            const float* lg = ln_g + 1 * D; const float* lb = ln_b + 1 * D;
            nk_ln_mod<<<NTOK / 4, 256, 0, stream>>>(xp, xs, out, 1, lg, lb, mods_l, 0, 1, H);
            float* QKV = R1; float* Oc = R1 + (size_t)80 * MB / 4; float* Yc = R1 + (size_t)100 * MB / 4;
            for (int c0 = 0; c0 < NTOK; c0 += CH) { const int b = tok_b(c0), s0 = seq_start(b), s1 = s0 + seq_len(b);
                int k0 = c0 - 7 * 64; if (k0 < s0) k0 = s0; int k1 = c0 + CH + 7 * 64; if (k1 > s1) k1 = s1; const int kr = k1 - k0;
                nk_gemm<0><<<dim3(3072 / 64, (kr + 63) / 64), 256, 0, stream>>>(H + (size_t)k0 * D, D, w_qkv, 3072, b_qkv, QKV, 3072, kr, 3072, D);
                nk_na_attn<<<CH * 16 / 4, 256, 0, stream>>>(QKV, k0, c0, rpb, Oc);
                nk_gemm<0><<<dim3(D / 64, CH / 64), 256, 0, stream>>>(Oc, D, w_o, D, b_o, Yc, D, CH, D, D);
                nk_residual<<<CH / 4, 256, 0, stream>>>(xp, xs, out, 1, lg, lb, mods_l, 2, Yc, 0, c0, nullptr); }
        }
        if (first_stage > (layer == 0 ? 1 : 3)) continue;
        const float* lg = ln_g + (layer * 2 + 0) * D; const float* lb = ln_b + (layer * 2 + 0) * D;
        nk_ln_mod<<<NTOK / 4, 256, 0, stream>>>(xp, xs, out, 1, lg, lb, mods_l, 3, 4, H);
        float* UG = R1; float* Ac = R1 + (size_t)96 * MB / 4; float* Yc = R1 + (size_t)144 * MB / 4;
        const float* wi = w_in + (size_t)layer * D * 2 * DFF; const float* bi = b_in + (size_t)layer * 2 * DFF;
        const float* cw = conv_w + (size_t)layer * 3 * DFF; const float* cb = conv_b + (size_t)layer * DFF;
        const float* wo = w_out + (size_t)layer * DFF * D; const float* bo = b_out + (size_t)layer * D;
        for (int c0 = 0; c0 < NTOK; c0 += CH) { const int b = tok_b(c0), s0 = seq_start(b), s1 = s0 + seq_len(b);
            int u0 = c0 - 1; if (u0 < s0) u0 = s0; int u1 = c0 + CH + 1; if (u1 > s1) u1 = s1; const int ur = u1 - u0;
            nk_gemm<0><<<dim3(2 * DFF / 64, (ur + 63) / 64), 256, 0, stream>>>(H + (size_t)u0 * D, D, wi, 2 * DFF, bi, UG, 2 * DFF, ur, 2 * DFF, D);
            nk_convgate<<<(CH * DFF + 255) / 256, 256, 0, stream>>>(UG, u0, c0, CH, cw, cb, Ac);
            nk_gemm<0><<<dim3(D / 64, CH / 64), 256, 0, stream>>>(Ac, DFF, wo, D, bo, Yc, D, CH, D, DFF);
            nk_residual<<<CH / 4, 256, 0, stream>>>(xp, xs, out, 1, lg, lb, mods_l, 5, Yc, 0, c0, nullptr); }
    }
    nk_final_ln<<<NTOK / 4, 256, 0, stream>>>(out, ln_g + 3 * D, ln_b + 3 * D);
}

extern "C" void kernel_launch(void* const* d_in, const int* in_sizes, int n_in, void* d_out, int out_size, void* d_ws, size_t ws_size, hipStream_t stream) {
    static int grid = 0;
    if (grid == 0) {
        if (n_in != 29 || out_size != NTOK * D || ws_size < WS_NEED) { fprintf(stderr, "kernel_launch: unexpected problem (n_in %d, out %d, ws %zu < %zu)\n", n_in, out_size, ws_size, (size_t)WS_NEED); grid = -1; return; }
        int dev = 0, cus = 0, per_cu = 0;
        hipGetDevice(&dev); hipDeviceGetAttribute(&cus, hipDeviceAttributeMultiprocessorCount, dev);
        if (hipFuncSetAttribute((const void*)k_fwd, hipFuncAttributeMaxDynamicSharedMemorySize, LDS_BYTES) != hipSuccess) { fprintf(stderr, "kernel_launch: hipFuncSetAttribute failed\n"); grid = -1; return; }
        hipOccupancyMaxActiveBlocksPerMultiprocessor(&per_cu, (const void*)k_fwd, NTHR, LDS_BYTES);
        if (per_cu < 1) { fprintf(stderr, "kernel_launch: occupancy query reports %d blocks per CU\n", per_cu); (void)hipGetLastError(); }
        grid = cus;
    }
    if (grid < 0) return;
    Params p{};
    for (int i = 0; i < 29; ++i) p.in[i] = (const float*)d_in[i];
    p.out = (float*)d_out; p.ws = (unsigned char*)d_ws;
    const int stage_end[6] = {0, 6, 8, 11, 13, 14};
    const int nph = stage_end[MK_NOPT];
    if (nph > 0) {
        (void)hipMemsetAsync((char*)d_ws + WS_CTL, 0, 64 * 1024, stream);
        if (MK_ONE && MK_NOPT == 5) {
            int lo = 0, hi = N_PHASES; void* args[] = {&p, &lo, &hi};
            hipError_t e = hipLaunchCooperativeKernel((const void*)k_fwd, dim3(grid), dim3(NTHR), args, LDS_BYTES, stream);
            if (e != hipSuccess) fprintf(stderr, "cooperative launch failed: %s (grid %d)\n", hipGetErrorString(e), grid);
        } else {
            for (int ph = 0; ph < nph; ++ph) hipLaunchKernelGGL(k_fwd, dim3(grid), dim3(NTHR), LDS_BYTES, stream, p, ph, ph + 1);
        }
    }
    naive_tail(MK_NOPT, d_in, (float*)d_out, (char*)d_ws, stream);
}
```

```cpp
#define MK_NOPT 5
#define MK_ONE 1
#define MK_DUPSUB 0
#include <hip/hip_runtime.h>
#include <hip/hip_cooperative_groups.h>
#include <cstdio>
#include <math.h>
namespace cg = cooperative_groups;
#define LAS __attribute__((address_space(3)))
typedef unsigned short bf16_t;
typedef short bf16x8 __attribute__((ext_vector_type(8)));
typedef short s16x4 __attribute__((ext_vector_type(4)));
typedef float f32x4 __attribute__((ext_vector_type(4)));
typedef unsigned u32x4 __attribute__((ext_vector_type(4)));
typedef unsigned u32x2 __attribute__((ext_vector_type(2)));

constexpr int NTOK = 49152, D = 1024, NB = 9, DFF = 2816, NPROMPT = 16384, SSEQ = 4096;
constexpr float ALPHA = 1.41421356237309515f;
constexpr float LN_EPS = 1e-5f;
constexpr int NTHR = 512;

__device__ __host__ inline int tok_b(int t) { return t < NPROMPT ? 0 : 1 + ((t - NPROMPT) >> 12); }
__device__ __host__ inline int seq_start(int b) { return b == 0 ? 0 : NPROMPT + (b - 1) * SSEQ; }
__device__ __host__ inline int seq_len(int b) { return b == 0 ? NPROMPT : SSEQ; }

__device__ __forceinline__ unsigned cvt_pk_bf16(float lo, float hi) { unsigned r; asm volatile("v_cvt_pk_bf16_f32 %0, %1, %2" : "=v"(r) : "v"(lo), "v"(hi)); return r; }
__device__ __forceinline__ bf16_t f2bf(float f) { return (bf16_t)(cvt_pk_bf16(f, 0.f) & 0xffffu); }
__device__ __forceinline__ float sigmoid_f(float x) { return __builtin_amdgcn_rcpf(1.0f + __expf(-x)); }
__device__ __forceinline__ float gelu_f(float x) { const float u2 = 1.5957691216057308f * x * (1.0f + 0.044715f * x * x); return x * __builtin_amdgcn_rcpf(1.0f + __expf(-u2)); }
__device__ __forceinline__ u32x4 pack8(const f32x4& a, const f32x4& b) { u32x4 w; w.x = cvt_pk_bf16(a[0], a[1]); w.y = cvt_pk_bf16(a[2], a[3]); w.z = cvt_pk_bf16(b[0], b[1]); w.w = cvt_pk_bf16(b[2], b[3]); return w; }
__device__ __forceinline__ int lane_id_asm() { int l_; asm volatile("v_mbcnt_lo_u32_b32 %0, -1, 0\n\tv_mbcnt_hi_u32_b32 %0, -1, %0" : "=v"(l_)); return l_; }
__device__ __forceinline__ float quad_sum(float x) {
    const u32x2 r = __builtin_amdgcn_permlane16_swap(__float_as_uint(x), __float_as_uint(x), false, false); const float s = __uint_as_float(r[0]) + __uint_as_float(r[1]);
    const u32x2 q = __builtin_amdgcn_permlane32_swap(__float_as_uint(s), __float_as_uint(s), false, false); return __uint_as_float(q[0]) + __uint_as_float(q[1]); }
__device__ __forceinline__ void atomic_add_f32(float* p, float v) { (void)__hip_atomic_fetch_add(p, v, __ATOMIC_RELAXED, __HIP_MEMORY_SCOPE_AGENT); }

constexpr int BK = 64, HTB = 128 * BK * 2  , STAGE_BYTES = 8 * HTB, NXCD = 8, WGM = 8;
__host__ __device__ __forceinline__ int lds_byte(int r, int c) { const int st = (r >> 4) * 2 + (c >> 5), rr = r & 15, cc = c & 31, ob = rr * 64 + cc * 2; return st * 1024 + (ob ^ (((ob >> 9) & 1) << 5)); }
__host__ __device__ __forceinline__ void stage_rc(int b, int& R, int& C) { const int st = b / 1024, sb = b % 1024, swz = sb ^ (((sb >> 9) & 1) << 5); R = (st >> 1) * 16 + swz / 64; C = (st & 1) * 32 + (swz % 64) / 2; }
__host__ __device__ __forceinline__ int perm32(int rho) { const int n = rho >> 4, i = rho & 15; return 8 * (i >> 2) + 4 * n + (i & 3); }
__host__ __device__ __forceinline__ int col_of(int np) { return (np & ~31) + perm32(np & 31); }

struct Unit { const char* a0; const char* a1; const char* b; int i0, i1; };
struct GShape { int nt; unsigned a_rs, a_gs, b_rs; };

struct TileOrder {
    int nM, nN, nwg, G, c;
    __device__ void init(int nM_, int nN_, int G_, int c_) { nM = nM_; nN = nN_; nwg = nM * nN; G = G_; c = c_; }
    __device__ bool get(int i, int& pm, int& pn) const {
        const long L = (long)i * G + c; if (L >= nwg) return false;
        int wgid = (int)L; { const int q = nwg / NXCD, r = nwg % NXCD, xcd = wgid % NXCD, off = wgid / NXCD; wgid = (xcd < r ? xcd * (q + 1) : r * (q + 1) + (xcd - r) * q) + off; }
        const int nig = WGM * nN, gid = wgid / nig, fm = gid * WGM, gsz = (nM - fm) < WGM ? (nM - fm) : WGM;
        pm = fm + ((wgid % nig) % gsz); pn = (wgid % nig) / gsz; return true;
    }
};

template <class Epi, class Sched>
__device__ __forceinline__ void gemm_phase(LAS unsigned char* lds, const GShape g, const Sched& S, const Epi& E, const int tid) {
    const int wid = __builtin_amdgcn_readfirstlane(tid >> 6), lane = tid & 63, wr = wid >> 2, wc = wid & 3, fr = lane & 15, fq = lane >> 4;
    const int nt = g.nt;
    unsigned voffA[2], voffB[2];
#pragma unroll
    for (int i = 0; i < 2; ++i) { int R, C; stage_rc(tid * 16 + i * 8192, R, C);
        voffA[i] = (unsigned)(R & 63) * g.a_rs + (unsigned)(C >> 4) * g.a_gs + (unsigned)(C & 15) * 2u; voffB[i] = (unsigned)R * g.b_rs + (unsigned)C * 2u; }
    const size_t kstepA = (size_t)g.a_gs * 4, kstepB = (size_t)(BK * 2);
    const size_t hstepA = (size_t)g.a_rs * 64, hstepB = (size_t)g.b_rs * 128;
    const unsigned ldsw = (unsigned)wid * 1024u;
    const int aoff = lds_byte(wr * 64 + fr, fq * 8), boff = lds_byte(wc * 32 + fr, fq * 8);
#define G_SA(b, h) (((b) * 2 + (h)) * HTB)
#define G_SB(b, h) ((4 + (b) * 2 + (h)) * HTB)
#define G_GLDS(src, dstoff) __builtin_amdgcn_global_load_lds((const unsigned*)(src), (LAS unsigned*)(lds + (dstoff)), 16, 0, 0)
#define G_STAGE_A(bufoff, p0, p1) do { G_GLDS((p0) + voffA[0], (bufoff) + ldsw); G_GLDS((p1) + voffA[1], (bufoff) + ldsw + 8192); } while (0)
#define G_STAGE_B(bufoff, pb) do { G_GLDS((pb) + voffB[0], (bufoff) + ldsw); G_GLDS((pb) + voffB[1], (bufoff) + ldsw + 8192); } while (0)
#define G_LDA(dst, b, h) do { _Pragma("unroll") for (int m = 0; m < 4; ++m) _Pragma("unroll") for (int k = 0; k < 2; ++k) dst[m][k] = *(const LAS bf16x8*)(lds + G_SA(b, h) + aoff + m * 2048 + k * 1024); } while (0)
#define G_LDB(dst, b, h) do { _Pragma("unroll") for (int n = 0; n < 2; ++n) _Pragma("unroll") for (int k = 0; k < 2; ++k) dst[n][k] = *(const LAS bf16x8*)(lds + G_SB(b, h) + boff + n * 2048 + k * 1024); } while (0)
#define G_MMA(ai, bj, At, Bt) do { __builtin_amdgcn_s_setprio(1); _Pragma("unroll") for (int m = 0; m < 4; ++m) _Pragma("unroll") for (int n = 0; n < 2; ++n) _Pragma("unroll") for (int k = 0; k < 2; ++k) \
        acc[ai][bj][m][n] = __builtin_amdgcn_mfma_f32_16x16x32_bf16(Bt[n][k], At[m][k], acc[ai][bj][m][n], 0, 0, 0); __builtin_amdgcn_s_setprio(0); } while (0)
#define G_WAIT_V(n) asm volatile("s_waitcnt vmcnt(" #n ")" ::: "memory")
#define G_WAIT_L(n) asm volatile("s_waitcnt lgkmcnt(" #n ")" ::: "memory")
#define G_BAR __builtin_amdgcn_s_barrier()
#define G_SCHED __builtin_amdgcn_sched_barrier(0)
    Unit cur, nxt; int ui = 0;
    if (!S.next(0, cur)) return;
    f32x4 acc[2][2][4][2];
#pragma unroll
    for (int a = 0; a < 2; ++a)
#pragma unroll
        for (int b = 0; b < 2; ++b)
#pragma unroll
            for (int m = 0; m < 4; ++m)
#pragma unroll
                for (int n = 0; n < 2; ++n) acc[a][b][m][n] = (f32x4){0.f, 0.f, 0.f, 0.f};
    bf16x8 At[4][2], B0[2][2], B1[2][2];
    const char* cA0 = cur.a0; const char* cA1 = cur.a1; const char* cB = cur.b;
    G_STAGE_B(G_SB(0, 0), cB); G_STAGE_B(G_SB(0, 1), cB + hstepB); G_STAGE_A(G_SA(0, 0), cA0, cA1); G_STAGE_A(G_SA(0, 1), cA0 + hstepA, cA1 + hstepA);
    if (wr == 1) G_BAR;
    G_WAIT_V(2); G_BAR;
    G_STAGE_B(G_SB(1, 0), cB + kstepB); G_STAGE_A(G_SA(1, 0), cA0 + kstepA, cA1 + kstepA); G_STAGE_B(G_SB(1, 1), cB + hstepB + kstepB);
    G_WAIT_V(6); G_BAR;
    for (;;) {
        const bool has_next = S.next(ui + 1, nxt);
        const char* nA0 = has_next ? nxt.a0 : cA0; const char* nA1 = has_next ? nxt.a1 : cA1; const char* nB = has_next ? nxt.b : cB;
        for (int t = 0; t < nt; t += 2) {
            const bool last = (t == nt - 2);
            const char* a1_0 = cA0 + (size_t)(t + 1) * kstepA; const char* a1_1 = cA1 + (size_t)(t + 1) * kstepA;
            const char* a2_0 = last ? nA0 : cA0 + (size_t)(t + 2) * kstepA; const char* a2_1 = last ? nA1 : cA1 + (size_t)(t + 2) * kstepA;
            const char* b2 = last ? nB : cB + (size_t)(t + 2) * kstepB;
            const char* a3_0 = a2_0 + kstepA; const char* a3_1 = a2_1 + kstepA; const char* b3 = b2 + kstepB;
            G_LDB(B0, 0, 0); G_LDB(B1, 0, 1); G_SCHED; G_LDA(At, 0, 0); G_STAGE_A(G_SA(1, 1), a1_0 + hstepA, a1_1 + hstepA);
            G_WAIT_V(8); G_WAIT_L(0); G_BAR; G_MMA(0, 0, At, B0); G_MMA(0, 1, At, B1); G_BAR; G_SCHED;
            G_LDA(At, 0, 1); G_STAGE_B(G_SB(0, 0), b2); G_STAGE_B(G_SB(0, 1), b2 + hstepB); G_STAGE_A(G_SA(0, 0), a2_0, a2_1);
            G_WAIT_V(8); G_WAIT_L(0); G_BAR; G_MMA(1, 0, At, B0); G_MMA(1, 1, At, B1); G_BAR; G_SCHED;
            G_LDB(B0, 1, 0); G_LDB(B1, 1, 1); G_SCHED; G_LDA(At, 1, 0); G_STAGE_A(G_SA(0, 1), a2_0 + hstepA, a2_1 + hstepA);
            G_WAIT_V(8); G_WAIT_L(0); G_BAR; G_MMA(0, 0, At, B0); G_MMA(0, 1, At, B1); G_BAR; G_SCHED;
            G_LDA(At, 1, 1); G_STAGE_B(G_SB(1, 0), b3); G_STAGE_B(G_SB(1, 1), b3 + hstepB); G_STAGE_A(G_SA(1, 0), a3_0, a3_1);
            G_WAIT_V(8); G_WAIT_L(0); G_BAR; G_MMA(1, 0, At, B0); G_MMA(1, 1, At, B1); G_BAR; G_SCHED;
        }
        if (wr == 0) G_BAR;
        { int l_; asm volatile("v_mbcnt_lo_u32_b32 %0, -1, 0\n\tv_mbcnt_hi_u32_b32 %0, -1, %0" : "=v"(l_));
          E(acc, cur, wr, wc, l_ & 15, l_ >> 4); }
        if (!has_next) break;
#pragma unroll
        for (int a = 0; a < 2; ++a)
#pragma unroll
            for (int b = 0; b < 2; ++b)
#pragma unroll
                for (int m = 0; m < 4; ++m)
#pragma unroll
                    for (int n = 0; n < 2; ++n) acc[a][b][m][n] = (f32x4){0.f, 0.f, 0.f, 0.f};
        cur = nxt; cA0 = nA0; cA1 = nA1; cB = nB; ++ui;
        if (wr == 1) G_BAR;
    }
    G_WAIT_V(0);
    G_BAR;
#undef G_SA
#undef G_SB
#undef G_GLDS
#undef G_STAGE_A
#undef G_STAGE_B
#undef G_LDA
#undef G_LDB
#undef G_MMA
#undef G_WAIT_V
#undef G_WAIT_L
#undef G_BAR
#undef G_SCHED
}
namespace nk {
__device__ inline float gelu_tanh(float x) { const float u = 0.7978845608028654f * (x + 0.044715f * x * x * x); return 0.5f * x * (1.0f + tanhf(u)); }
__device__ inline float wave_sum(float v) { for (int o = 32; o >= 1; o >>= 1) v += __shfl_xor(v, o); return v; }

__global__ void nk_mods(const float* cp, const float* cs, const float* w_ada, const float* b_ada, float* mods) {
    __shared__ float cond[NB][D];
    for (int i = threadIdx.x; i < NB * D; i += 256) { const int b = i / D, k = i % D; const float c = b == 0 ? cp[k] : cs[(b - 1) * D + k]; cond[b][k] = c / (1.0f + expf(-c)); }
    __syncthreads();
    const int col = blockIdx.x * 256 + threadIdx.x, layer = col / 6144, n = col % 6144;
    float acc[NB];
    for (int b = 0; b < NB; ++b) acc[b] = 0.f;
    const float* w = w_ada + (size_t)layer * D * 6144 + n;
    for (int k = 0; k < D; ++k) { const float wv = w[(size_t)k * 6144]; for (int b = 0; b < NB; ++b) acc[b] += cond[b][k] * wv; }
    for (int b = 0; b < NB; ++b) mods[(size_t)(layer * NB + b) * 6144 + n] = acc[b] + b_ada[layer * 6144 + n];
}

__global__ void nk_ln_mod(const float* xp, const float* xs, const float* v, int use_ln, const float* lng, const float* lnb, const float* mods_l, int sh_off, int sc_off, float* H) {
    const int row = blockIdx.x * 4 + (threadIdx.x >> 6), lane = threadIdx.x & 63, b = tok_b(row);
    const float* src = use_ln ? v + (size_t)row * D : (row < NPROMPT ? xp + (size_t)row * D : xs + (size_t)(row - NPROMPT) * D);
    float4 x[4];
    for (int j = 0; j < 4; ++j) x[j] = *(const float4*)(src + j * 256 + lane * 4);
    if (use_ln) {
        float s = 0.f; for (int j = 0; j < 4; ++j) s += x[j].x + x[j].y + x[j].z + x[j].w;
        const float mean = wave_sum(s) * (1.0f / D);
        float q = 0.f; for (int j = 0; j < 4; ++j) { float d0 = x[j].x - mean, d1 = x[j].y - mean, d2 = x[j].z - mean, d3 = x[j].w - mean; q += d0 * d0 + d1 * d1 + d2 * d2 + d3 * d3; }
        const float rstd = rsqrtf(wave_sum(q) * (1.0f / D) + LN_EPS);
        for (int j = 0; j < 4; ++j) { const int n = j * 256 + lane * 4; const float4 g = *(const float4*)(lng + n), bb = *(const float4*)(lnb + n);
            x[j].x = (x[j].x - mean) * rstd * g.x + bb.x; x[j].y = (x[j].y - mean) * rstd * g.y + bb.y; x[j].z = (x[j].z - mean) * rstd * g.z + bb.z; x[j].w = (x[j].w - mean) * rstd * g.w + bb.w; }
    }
    const float* m = mods_l + (size_t)b * 6144;
    for (int j = 0; j < 4; ++j) { const int n = j * 256 + lane * 4; const float4 sc = *(const float4*)(m + sc_off * D + n), sh = *(const float4*)(m + sh_off * D + n);
        float4 o; o.x = x[j].x * (1.f + sc.x) + sh.x; o.y = x[j].y * (1.f + sc.y) + sh.y; o.z = x[j].z * (1.f + sc.z) + sh.z; o.w = x[j].w * (1.f + sc.w) + sh.w;
        *(float4*)(H + (size_t)row * D + n) = o; }
}

template <int ACT> __global__ void nk_gemm(const float* A, int lda, const float* W, int ldw, const float* bias, float* C, int ldc, int M, int N, int K) {
    __shared__ float As[16][68], Ws[16][64];
    const int tid = threadIdx.x, tx = tid & 15, ty = tid >> 4, m0 = blockIdx.y * 64, n0 = blockIdx.x * 64;
    float acc[4][4];
    for (int i = 0; i < 4; ++i) for (int j = 0; j < 4; ++j) acc[i][j] = 0.f;
    const int ar = tid >> 2, ak = (tid & 3) * 4; int arow = m0 + ar; if (arow >= M) arow = M - 1;
    const int wr = tid >> 4, wc = (tid & 15) * 4;
    for (int k0 = 0; k0 < K; k0 += 16) {
        float4 a = *(const float4*)(A + (size_t)arow * lda + k0 + ak);
        if (ACT == 1) { a.x = gelu_tanh(a.x); a.y = gelu_tanh(a.y); a.z = gelu_tanh(a.z); a.w = gelu_tanh(a.w); }
        const float4 w = *(const float4*)(W + (size_t)(k0 + wr) * ldw + n0 + wc);
        As[ak + 0][ar] = a.x; As[ak + 1][ar] = a.y; As[ak + 2][ar] = a.z; As[ak + 3][ar] = a.w;
        *(float4*)&Ws[wr][wc] = w;
        __syncthreads();
#pragma unroll
        for (int kk = 0; kk < 16; ++kk) { const float4 av = *(const float4*)&As[kk][ty * 4]; const float4 wv = *(const float4*)&Ws[kk][tx * 4];
            const float aa[4] = {av.x, av.y, av.z, av.w}, ww[4] = {wv.x, wv.y, wv.z, wv.w};
#pragma unroll
            for (int i = 0; i < 4; ++i)
#pragma unroll
                for (int j = 0; j < 4; ++j) acc[i][j] += aa[i] * ww[j]; }
        __syncthreads();
    }
    for (int i = 0; i < 4; ++i) { const int r = m0 + ty * 4 + i; if (r >= M) continue;
        float4 o; const int c = n0 + tx * 4; o.x = acc[i][0] + bias[c]; o.y = acc[i][1] + bias[c + 1]; o.z = acc[i][2] + bias[c + 2]; o.w = acc[i][3] + bias[c + 3];
        *(float4*)(C + (size_t)r * ldc + c) = o; }
}

__global__ void nk_dskip(const float* H, const float* d, float* Y) { const size_t i = (size_t)blockIdx.x * 256 + threadIdx.x; Y[i] = H[i] * d[i & (D - 1)]; }

__global__ void nk_s5_scan(const float* H, float* Y, int dir, const float* lam_re, const float* lam_im, const float* log_dt, const float* b_re, const float* b_im, const float* c_re, const float* c_im) {
    const int b = blockIdx.x / 64, g = blockIdx.x % 64, p = threadIdx.x;
    const int idx = (dir * 64 + g) * 64 + p;
    const double dt = exp((double)log_dt[dir * 64 + g]), lr = lam_re[idx], li = lam_im[idx];
    const double zr = lr * dt, zi = li * dt, mag = exp(zr), abr_d = mag * cos(zi), abi_d = mag * sin(zi);
    const double den = lr * lr + li * li, nr = abr_d - 1.0, ni = abi_d, fr = (nr * lr + ni * li) / den, fi = (ni * lr - nr * li) / den;
    float bbr[16], bbi[16], cr[16], ci[16];
    for (int h = 0; h < 16; ++h) { const double br = b_re[(size_t)idx * 16 + h], bi = b_im[(size_t)idx * 16 + h]; bbr[h] = (float)(fr * br - fi * bi); bbi[h] = (float)(fr * bi + fi * br);
        cr[h] = c_re[((size_t)(dir * 64 + g) * 16 + h) * 64 + p]; ci[h] = c_im[((size_t)(dir * 64 + g) * 16 + h) * 64 + p]; }
    const float abr = (float)abr_d, abi = (float)abi_d;
    const int s0 = seq_start(b), S = seq_len(b);
    float sr = 0.f, si = 0.f;
    for (int i = 0; i < S; ++i) {
        const int t = s0 + (dir == 0 ? i : S - 1 - i);
        const float* u = H + (size_t)t * D + g * 16;
        float bur = 0.f, bui = 0.f;
#pragma unroll
        for (int h = 0; h < 16; ++h) { const float uv = u[h]; bur += uv * bbr[h]; bui += uv * bbi[h]; }
        const float nsr = abr * sr - abi * si + bur, nsi = abr * si + abi * sr + bui; sr = nsr; si = nsi;
        float mine = 0.f;
#pragma unroll
        for (int h = 0; h < 16; ++h) { const float r = wave_sum(cr[h] * sr - ci[h] * si); if (p == h) mine = r; }
        if (p < 16) Y[(size_t)t * D + g * 16 + p] += mine;
    }
}

__global__ void nk_residual(const float* xp, const float* xs, float* vio, int use_ln, const float* lng, const float* lnb, const float* mods_l, int gate_off, const float* Ysrc, int glu, int row0, float* stats) {
    const int rc = blockIdx.x * 4 + (threadIdx.x >> 6), row = row0 + rc, lane = threadIdx.x & 63, b = tok_b(row);
    const float* src = use_ln ? vio + (size_t)row * D : (row < NPROMPT ? xp + (size_t)row * D : xs + (size_t)(row - NPROMPT) * D);
    float4 x[4];
    for (int j = 0; j < 4; ++j) x[j] = *(const float4*)(src + j * 256 + lane * 4);
    if (use_ln) {
        float s = 0.f; for (int j = 0; j < 4; ++j) s += x[j].x + x[j].y + x[j].z + x[j].w;
        const float mean = wave_sum(s) * (1.0f / D);
        float q = 0.f; for (int j = 0; j < 4; ++j) { float d0 = x[j].x - mean, d1 = x[j].y - mean, d2 = x[j].z - mean, d3 = x[j].w - mean; q += d0 * d0 + d1 * d1 + d2 * d2 + d3 * d3; }
        const float rstd = rsqrtf(wave_sum(q) * (1.0f / D) + LN_EPS);
        for (int j = 0; j < 4; ++j) { const int n = j * 256 + lane * 4; const float4 g = *(const float4*)(lng + n), bb = *(const float4*)(lnb + n);
            x[j].x = (x[j].x - mean) * rstd * g.x + bb.x; x[j].y = (x[j].y - mean) * rstd * g.y + bb.y; x[j].z = (x[j].z - mean) * rstd * g.z + bb.z; x[j].w = (x[j].w - mean) * rstd * g.w + bb.w; }
    }
    const float* gate = mods_l + (size_t)b * 6144 + gate_off * D;
    float s1 = 0.f, s2 = 0.f;
    for (int j = 0; j < 4; ++j) { const int n = j * 256 + lane * 4; float4 y;
        if (glu) { const float4 a = *(const float4*)(Ysrc + (size_t)rc * 2048 + n), g = *(const float4*)(Ysrc + (size_t)rc * 2048 + 1024 + n);
            y.x = a.x / (1.f + expf(-g.x)); y.y = a.y / (1.f + expf(-g.y)); y.z = a.z / (1.f + expf(-g.z)); y.w = a.w / (1.f + expf(-g.w)); }
        else y = *(const float4*)(Ysrc + (size_t)rc * D + n);
        const float4 gt = *(const float4*)(gate + n);
        float4 o; o.x = ALPHA * x[j].x + gt.x * y.x; o.y = ALPHA * x[j].y + gt.y * y.y; o.z = ALPHA * x[j].z + gt.z * y.z; o.w = ALPHA * x[j].w + gt.w * y.w;
        s1 += o.x + o.y + o.z + o.w; s2 += o.x * o.x + o.y * o.y + o.z * o.z + o.w * o.w;
        *(float4*)(vio + (size_t)row * D + n) = o; }
    s1 = wave_sum(s1); s2 = wave_sum(s2);
    if (lane == 0 && stats) { stats[row * 2] = s1; stats[row * 2 + 1] = s2; }
}

__global__ void nk_convgate(const float* UG, int ug0, int t0, int rows, const float* cw, const float* cb, float* Ac) {
    const size_t i = (size_t)blockIdx.x * 256 + threadIdx.x; if (i >= (size_t)rows * DFF) return;
    const int r = (int)(i / DFF), ch = (int)(i % DFF), t = t0 + r, b = tok_b(t), s0 = seq_start(b), s1 = s0 + seq_len(b);
    const float* u = UG + (size_t)(t - ug0) * (2 * DFF) + ch;
    const float up = (t - 1 >= s0) ? u[-(2 * DFF)] : 0.f, uc = u[0], un = (t + 1 < s1) ? u[2 * DFF] : 0.f;
    const float c = up * cw[ch] + uc * cw[DFF + ch] + un * cw[2 * DFF + ch] + cb[ch];
    Ac[(size_t)r * DFF + ch] = gelu_tanh(c) * u[DFF];
}

__global__ void nk_na_attn(const float* QKV, int kv0, int t0, const float* rpb, float* Oc) {
    const int wid = blockIdx.x * 4 + (threadIdx.x >> 6), lane = threadIdx.x & 63;
    const int r = wid >> 4, h = wid & 15, t = t0 + r, b = tok_b(t), s0 = seq_start(b), nrows = seq_len(b) / 64;
    const int tl = t - s0, gr = tl >> 6, gc = tl & 63;
    int rs = gr - 4; rs = rs < 0 ? 0 : (rs > nrows - 8 ? nrows - 8 : rs);
    int cs = gc - 8; cs = cs < 0 ? 0 : (cs > 48 ? 48 : cs);
    __shared__ float qs[4][64]; __shared__ float ps[4][128];
    const int w = threadIdx.x >> 6;
    qs[w][lane] = QKV[(size_t)(t - kv0) * 3072 + h * 64 + lane] * 0.125f;
    __syncthreads();
    float sc[2];
    for (int j = 0; j < 2; ++j) { const int kk = lane + j * 64, kr = rs + (kk >> 4), kc = cs + (kk & 15), kt = s0 + kr * 64 + kc;
        const float* kp = QKV + (size_t)(kt - kv0) * 3072 + 1024 + h * 64; float s = 0.f;
        for (int d = 0; d < 64; d += 4) { const float4 kv = *(const float4*)(kp + d); s += qs[w][d] * kv.x + qs[w][d + 1] * kv.y + qs[w][d + 2] * kv.z + qs[w][d + 3] * kv.w; }
        sc[j] = s + rpb[(h * 15 + (kr - gr + 7)) * 31 + (kc - gc + 15)]; }
    float m = fmaxf(sc[0], sc[1]); for (int o = 32; o >= 1; o >>= 1) m = fmaxf(m, __shfl_xor(m, o));
    const float e0 = expf(sc[0] - m), e1 = expf(sc[1] - m); const float sum = wave_sum(e0 + e1);
    ps[w][lane] = e0 / sum; ps[w][lane + 64] = e1 / sum;
    __syncthreads();
    float o = 0.f;
    for (int kk = 0; kk < 128; ++kk) { const int kr = rs + (kk >> 4), kc = cs + (kk & 15), kt = s0 + kr * 64 + kc; o += ps[w][kk] * QKV[(size_t)(kt - kv0) * 3072 + 2048 + h * 64 + lane]; }
    Oc[(size_t)r * D + h * 64 + lane] = o;
}

__global__ void nk_final_ln(float* v, const float* lng, const float* lnb) {
    const int row = blockIdx.x * 4 + (threadIdx.x >> 6), lane = threadIdx.x & 63;
    float4 x[4];
    for (int j = 0; j < 4; ++j) x[j] = *(const float4*)(v + (size_t)row * D + j * 256 + lane * 4);
    float s = 0.f; for (int j = 0; j < 4; ++j) s += x[j].x + x[j].y + x[j].z + x[j].w;
    const float mean = wave_sum(s) * (1.0f / D);
    float q = 0.f; for (int j = 0; j < 4; ++j) { float d0 = x[j].x - mean, d1 = x[j].y - mean, d2 = x[j].z - mean, d3 = x[j].w - mean; q += d0 * d0 + d1 * d1 + d2 * d2 + d3 * d3; }
    const float rstd = rsqrtf(wave_sum(q) * (1.0f / D) + LN_EPS);
    for (int j = 0; j < 4; ++j) { const int n = j * 256 + lane * 4; const float4 g = *(const float4*)(lng + n), bb = *(const float4*)(lnb + n);
        float4 o; o.x = (x[j].x - mean) * rstd * g.x + bb.x; o.y = (x[j].y - mean) * rstd * g.y + bb.y; o.z = (x[j].z - mean) * rstd * g.z + bb.z; o.w = (x[j].w - mean) * rstd * g.w + bb.w;
        *(float4*)(v + (size_t)row * D + n) = o; }
}

}
constexpr size_t KiB = 1024, MiB = 1024 * 1024;
constexpr size_t WS_CTL = 0;
constexpr size_t WS_MODS = 64 * KiB;
constexpr size_t WS_CVEC = 512 * KiB;
constexpr size_t WS_GAM = 1536 * KiB;
constexpr size_t WS_STATS = 2 * MiB;
constexpr size_t WS_PW = 4 * MiB;
constexpr size_t WS_BBAR = 9 * MiB;
constexpr size_t WS_KTAB = 10 * MiB;
constexpr size_t WS_WGLU = 18 * MiB;
constexpr size_t WS_WIN = 22 * MiB;
constexpr size_t WS_WOUT = 44 * MiB;
constexpr size_t WS_WQKV = 55 * MiB;
constexpr size_t WS_WO = 61 * MiB;
constexpr size_t WS_S = 64 * MiB;
constexpr size_t WS_YG = WS_S;
constexpr size_t WS_BSEND = WS_S;
constexpr size_t WS_SEND = WS_S + 32 * MiB;
constexpr size_t WS_AS5 = WS_S + 96 * MiB;
constexpr size_t WS_BS5 = WS_S + 216 * MiB;
constexpr size_t WS_APR = WS_S + 288 * MiB + 4096;
constexpr size_t WS_A0 = WS_S;
constexpr size_t WS_QKV = WS_S;
constexpr size_t WS_O = WS_S + 288 * MiB;
constexpr size_t WS_APR3 = WS_S + 4096;
constexpr size_t WS_A1 = WS_S + 100 * MiB;
constexpr size_t WS_NEED = WS_S + 386 * MiB;
constexpr int CV_IN0 = 0, CV_QKV = 2 * 9 * 5632, CV_IN1 = CV_QKV + 2 * 9 * 3072;

struct Params { const float* in[29]; float* out; unsigned char* ws; };
enum { I_XP = 0, I_XS, I_CP, I_CS, I_WADA, I_BADA, I_LNG, I_LNB, I_LRE, I_LIM, I_LDT, I_BRE, I_BIM, I_CRE, I_CIM, I_SD, I_WGLU, I_BGLU, I_WQKV, I_BQKV, I_RPB, I_WO, I_BO, I_WIN, I_BIN, I_CW, I_CB, I_WOUT, I_BOUT };

__device__ __forceinline__ const float* xin_row(const Params& p, int t) { return t < NPROMPT ? p.in[I_XP] + (size_t)t * D : p.in[I_XS] + (size_t)(t - NPROMPT) * D; }
__device__ __forceinline__ void row_stats(const float* st, int tok, float& mean, float& rstd) {
    const float2 s = *(const float2*)(st + (size_t)tok * 2); mean = s.x * (1.0f / D); const float var = s.y * (1.0f / D) - mean * mean; rstd = rsqrtf(fmaxf(var, 0.f) + LN_EPS); }

struct SchedPlain {
    TileOrder o; const char* A; const char* B; size_t a_rs, b_rs;
    __device__ bool next(int i, Unit& u) const { int pm, pn; if (!o.get(i, pm, pn)) return false;
        u.a0 = A + (size_t)(pm * 256) * a_rs; u.a1 = u.a0 + 128 * a_rs; u.b = B + (size_t)pn * 256 * b_rs; u.i0 = pm * 256; u.i1 = pn; return true; }
};
struct SchedS5 {
    TileOrder o; const char* A; const char* B; size_t b_gstride  , b_rs;
    __device__ bool next(int i, Unit& u) const { int pm, pn; if (!o.get(i, pm, pn)) return false; const int g = pm / 3;
        u.a0 = A + (size_t)(pm * 256) * 2560; u.a1 = u.a0 + (size_t)128 * 2560; u.b = B + (size_t)g * b_gstride + (size_t)pn * 256 * b_rs; u.i0 = pm * 256; u.i1 = pn; return true; }
};
__device__ __forceinline__ void ht_params(int ht, int& T, int& olo, int& ohi, int& s0, int& s1) {
    int b, jl;
    if (ht < 131) { b = 0; jl = ht; } else if (ht < 395) { b = 1 + (ht - 131) / 33; jl = (ht - 131) % 33; } else { T = 0; olo = 0; ohi = 0; s0 = 0; s1 = NPROMPT; return; }
    s0 = seq_start(b); s1 = s0 + seq_len(b); olo = s0 + 126 * jl; ohi = olo + 126 < s1 ? olo + 126 : s1; T = olo - 1;
}
constexpr int FFN_UNITS_M = 198;
struct SchedFfnIn {
    TileOrder o; const char* A; const char* B;
    __device__ bool next(int i, Unit& u) const { int pm, pn; if (!o.get(i, pm, pn)) return false; int T0, T1, a, b, c, d;
        ht_params(2 * pm, T0, a, b, c, d); ht_params(2 * pm + 1, T1, a, b, c, d);
        u.a0 = A + (long)T0 * 2048; u.a1 = A + (long)T1 * 2048; u.b = B + (size_t)pn * 256 * 2048; u.i0 = pm; u.i1 = pn; return true; }
};

typedef const f32x4 (&AccRef)[2][2][4][2];

struct EpiSend {
    float* C;
    __device__ __forceinline__ void operator()(AccRef acc, const Unit& u, int wr, int wc, int fr, int fq) const {
#pragma unroll
        for (int ai = 0; ai < 2; ++ai)
#pragma unroll
            for (int m = 0; m < 4; ++m) { float* p = C + (size_t)(u.i0 + 128 * wr + 64 * ai + 16 * m + fr) * 256 + 32 * wc + 8 * fq;
#pragma unroll
                for (int bj = 0; bj < 2; ++bj) { *(f32x4*)(p + 128 * bj) = acc[ai][bj][m][0]; *(f32x4*)(p + 128 * bj + 4) = acc[ai][bj][m][1]; } }
    }
};
struct EpiS5 {
    bf16_t* Y;
    __device__ __forceinline__ void operator()(AccRef acc, const Unit& u, int wr, int wc, int fr, int fq) const {
#pragma unroll
        for (int ai = 0; ai < 2; ++ai)
#pragma unroll
            for (int m = 0; m < 4; ++m) { bf16_t* p = Y + (size_t)(u.i0 + 128 * wr + 64 * ai + 16 * m + fr) * 1024 + u.i1 * 256 + 32 * wc + 8 * fq;
#pragma unroll
                for (int bj = 0; bj < 2; ++bj) { f32x4 v0 = acc[ai][bj][m][0], v1 = acc[ai][bj][m][1];
#pragma unroll
                    for (int j = 0; j < 4; ++j) { v0[j] = gelu_f(v0[j]); v1[j] = gelu_f(v1[j]); }
                    *(u32x4*)(p + 128 * bj) = pack8(v0, v1); }
                __builtin_amdgcn_sched_barrier(0); }
    }
};
struct EpiGlu {
    const float* xp; const float* xs; float* out; const float* bglu; const float* mods0; const float* gam; float* stats; bf16_t* apr; bool dry;
    __device__ __forceinline__ void operator()(AccRef acc, const Unit& u, int wr, int wc, int fr, int fq) const {
        const int b = tok_b(u.i0), oc0 = 128 * u.i1 + 32 * wc + 8 * fq;
        f32x4 ba[2], bg[2], gm[2], ga[2];
#pragma unroll
        for (int n = 0; n < 2; ++n) { ba[n] = *(const f32x4*)(bglu + oc0 + 4 * n); bg[n] = *(const f32x4*)(bglu + 1024 + oc0 + 4 * n);
            gm[n] = *(const f32x4*)(mods0 + (size_t)b * 6144 + 2 * D + oc0 + 4 * n); ga[n] = *(const f32x4*)(gam + (size_t)b * D + oc0 + 4 * n); }
        const float* xbase = u.i0 < NPROMPT ? xp : xs - (size_t)NPROMPT * D;
#pragma unroll
        for (int ai = 0; ai < 2; ++ai) {
            f32x4 x0[4][2];
#pragma unroll
            for (int m = 0; m < 4; ++m) { const unsigned tok = (unsigned)(u.i0 + 128 * wr + 64 * ai + 16 * m + fr); const float* xr = (const float*)((const char*)xbase + (tok * (unsigned)(D * 4) + (unsigned)oc0 * 4u));
                x0[m][0] = *(const f32x4*)xr; x0[m][1] = *(const f32x4*)(xr + 4); }
#pragma unroll
            for (int m = 0; m < 4; ++m) { const unsigned tok = (unsigned)(u.i0 + 128 * wr + 64 * ai + 16 * m + fr); float* vo = (float*)((char*)out + (tok * (unsigned)(D * 4) + (unsigned)oc0 * 4u));
                f32x4 v[2]; float s1 = 0.f, s2 = 0.f;
#pragma unroll
                for (int n = 0; n < 2; ++n) { const f32x4 a = acc[ai][0][m][n] + ba[n], g = acc[ai][1][m][n] + bg[n];
#pragma unroll
                    for (int j = 0; j < 4; ++j) { const float gl = a[j] * sigmoid_f(g[j]); const float vv = ALPHA * x0[m][n][j] + gm[n][j] * gl; v[n][j] = vv; s1 += vv; s2 += vv * vv; }
                    if (!dry) *(f32x4*)(vo + 4 * n) = v[n]; }
                if (!dry) *(u32x4*)((char*)apr + (tok * (unsigned)(D * 2) + (unsigned)oc0 * 2u)) = pack8(v[0] * ga[0], v[1] * ga[1]);
                s1 = quad_sum(s1); s2 = quad_sum(s2);
                if (!dry && fq == 0) { float* sp = (float*)((char*)stats + tok * 8u); atomic_add_f32(sp, s1); atomic_add_f32(sp + 1, s2); } }
            __builtin_amdgcn_sched_barrier(0); }
    }
};
struct EpiOut {
    float* vio; const float* bias; const float* lng; const float* lnb; const float* gate  ; const float* gam  ;
    const float* st_prev; float* st_next; bf16_t* apr; bool dry;
    template <int BJ> __device__ __forceinline__ void pass(AccRef acc, const Unit& u, int wr, int wc, int fr, int fq, int b) const {
        constexpr int RB = BJ == 0 ? 2 : 4;
        const int oc0 = 256 * u.i1 + 128 * BJ + 32 * wc + 8 * fq;
        f32x4 cp[2], cq[2], gt[2], ga[2];
#pragma unroll
        for (int n = 0; n < 2; ++n) { const f32x4 bi = *(const f32x4*)(bias + oc0 + 4 * n), lg = *(const f32x4*)(lng + oc0 + 4 * n), lb = *(const f32x4*)(lnb + oc0 + 4 * n);
            gt[n] = *(const f32x4*)(gate + (size_t)b * 6144 + oc0 + 4 * n); ga[n] = gam ? *(const f32x4*)(gam + (size_t)b * D + oc0 + 4 * n) : (f32x4){0.f, 0.f, 0.f, 0.f};
            cp[n] = lg * ALPHA; cq[n] = lb * ALPHA + gt[n] * bi; }
#pragma unroll
        for (int r0 = 0; r0 < 8; r0 += RB) {
            f32x4 vo[RB][2]; float2 st[RB];
#pragma unroll
            for (int q = 0; q < RB; ++q) { const int ai = (r0 + q) >> 2, m = (r0 + q) & 3; const unsigned tok = (unsigned)(u.i0 + 128 * wr + 64 * ai + 16 * m + fr); const float* vp = (const float*)((const char*)vio + (tok * (unsigned)(D * 4) + (unsigned)oc0 * 4u));
                vo[q][0] = *(const f32x4*)vp; vo[q][1] = *(const f32x4*)(vp + 4); st[q] = *(const float2*)((const char*)st_prev + tok * 8u); }
#pragma unroll
            for (int q = 0; q < RB; ++q) { const int ai = (r0 + q) >> 2, m = (r0 + q) & 3; const unsigned tok = (unsigned)(u.i0 + 128 * wr + 64 * ai + 16 * m + fr); float* vp = (float*)((char*)vio + (tok * (unsigned)(D * 4) + (unsigned)oc0 * 4u));
                const float mean = st[q].x * (1.0f / D), rstd = rsqrtf(fmaxf(st[q].y * (1.0f / D) - mean * mean, 0.f) + LN_EPS);
                f32x4 v[2]; float s1 = 0.f, s2 = 0.f;
#pragma unroll
                for (int n = 0; n < 2; ++n) {
#pragma unroll
                    for (int j = 0; j < 4; ++j) { const float vv = rstd * cp[n][j] * (vo[q][n][j] - mean) + cq[n][j] + gt[n][j] * acc[ai][BJ][m][n][j]; v[n][j] = vv; s1 += vv; s2 += vv * vv; }
                    if (!dry) *(f32x4*)(vp + 4 * n) = v[n]; }
                if (apr && !dry) *(u32x4*)((char*)apr + (tok * (unsigned)(D * 2) + (unsigned)oc0 * 2u)) = pack8(v[0] * ga[0], v[1] * ga[1]);
                s1 = quad_sum(s1); s2 = quad_sum(s2);
                if (st_next && !dry && fq == 0) { float* sp = (float*)((char*)st_next + tok * 8u); atomic_add_f32(sp, s1); atomic_add_f32(sp + 1, s2); } }
            __builtin_amdgcn_sched_barrier(0); }
    }
    __device__ __forceinline__ void operator()(AccRef acc, const Unit& u, int wr, int wc, int fr, int fq) const {
        const int b = tok_b(u.i0);
        pass<0>(acc, u, wr, wc, fr, fq, b); pass<1>(acc, u, wr, wc, fr, fq, b);
    }
};
struct EpiQkv {
    const float* c1; const float* c2; const float* st; bf16_t* O;
    __device__ __forceinline__ void operator()(AccRef acc, const Unit& u, int wr, int wc, int fr, int fq) const {
        const int b = tok_b(u.i0);
        float mean[2][4], rstd[2][4];
#pragma unroll
        for (int ai = 0; ai < 2; ++ai)
#pragma unroll
            for (int m = 0; m < 4; ++m) row_stats(st, u.i0 + 128 * wr + 64 * ai + 16 * m + fr, mean[ai][m], rstd[ai][m]);
#pragma unroll
        for (int bj = 0; bj < 2; ++bj) { const int oc0 = 256 * u.i1 + 128 * bj + 32 * wc + 8 * fq; const float sc = oc0 < 1024 ? 0.125f : 1.0f;
            f32x4 k1[2], k2[2];
#pragma unroll
            for (int n = 0; n < 2; ++n) { k1[n] = *(const f32x4*)(c1 + (size_t)b * 3072 + oc0 + 4 * n); k2[n] = *(const f32x4*)(c2 + (size_t)b * 3072 + oc0 + 4 * n); }
#pragma unroll
            for (int ai = 0; ai < 2; ++ai)
#pragma unroll
                for (int m = 0; m < 4; ++m) { const unsigned tok = (unsigned)(u.i0 + 128 * wr + 64 * ai + 16 * m + fr);
                    f32x4 v[2];
#pragma unroll
                    for (int n = 0; n < 2; ++n)
#pragma unroll
                        for (int j = 0; j < 4; ++j) v[n][j] = (rstd[ai][m] * (acc[ai][bj][m][n][j] - mean[ai][m] * k1[n][j]) + k2[n][j]) * sc;
                    *(u32x4*)((char*)O + (tok * 6144u + (unsigned)oc0 * 2u)) = pack8(v[0], v[1]); } }
    }
};
__device__ __forceinline__ float dpp_prev(float cur, float prevgrp) {
    const int rot = __builtin_amdgcn_update_dpp(0, __float_as_int(prevgrp), 0x121  , 0xf, 0xf, false);
    return __int_as_float(__builtin_amdgcn_update_dpp(rot, __float_as_int(cur), 0x111  , 0xf, 0xf, false)); }
__device__ __forceinline__ float dpp_next(float cur, float nextgrp) {
    const int rot = __builtin_amdgcn_update_dpp(0, __float_as_int(nextgrp), 0x12F  , 0xf, 0xf, false);
    return __int_as_float(__builtin_amdgcn_update_dpp(rot, __float_as_int(cur), 0x101  , 0xf, 0xf, false)); }
struct EpiFfnIn {
    const float* c1; const float* c2;   const float* st; const float* cw; const float* cb; bf16_t* O;
    __device__ __forceinline__ void operator()(f32x4 (&acc)[2][2][4][2], const Unit& u, int wr, int wc, int fr, int fq) const {
        int T, olo, ohi, s0, s1; ht_params(2 * u.i0 + wr, T, olo, ohi, s0, s1);
        const int b = tok_b(s0);
#pragma unroll
        for (int n = 0; n < 2; ++n) {
            const int oc = 128 * u.i1 + 32 * wc + 8 * fq + 4 * n;
            {
                const f32x4 k1u = *(const f32x4*)(c1 + (size_t)b * 5632 + oc), k2u = *(const f32x4*)(c2 + (size_t)b * 5632 + oc);
                const f32x4 k1g = *(const f32x4*)(c1 + (size_t)b * 5632 + DFF + oc), k2g = *(const f32x4*)(c2 + (size_t)b * 5632 + DFF + oc);
#pragma unroll
                for (int ai = 0; ai < 2; ++ai)
#pragma unroll
                    for (int m = 0; m < 4; ++m) { int tok = T + 64 * ai + 16 * m + fr; tok = tok < 0 ? 0 : (tok > NTOK - 1 ? NTOK - 1 : tok); float mean, rstd; row_stats(st, tok, mean, rstd);
#pragma unroll
                        for (int j = 0; j < 4; ++j) { acc[ai][0][m][n][j] = rstd * (acc[ai][0][m][n][j] - mean * k1u[j]) + k2u[j]; acc[ai][1][m][n][j] = rstd * (acc[ai][1][m][n][j] - mean * k1g[j]) + k2g[j]; } }
            }
            const f32x4 w0 = *(const f32x4*)(cw + oc), w1 = *(const f32x4*)(cw + DFF + oc), w2 = *(const f32x4*)(cw + 2 * DFF + oc), wb = *(const f32x4*)(cb + oc);
#pragma unroll
            for (int gi = 0; gi < 8; ++gi) { const int ai = gi >> 2, m = gi & 3, gp = gi > 0 ? gi - 1 : 0, gn = gi < 7 ? gi + 1 : 7;
                const int tok = T + 64 * ai + 16 * m + fr; const bool pv = tok - 1 >= s0, nv = tok + 1 < s1, ov = tok >= olo && tok < ohi;
                f32x4 r;
#pragma unroll
                for (int j = 0; j < 4; ++j) { const float uc = acc[ai][0][m][n][j];
                    float up = dpp_prev(uc, acc[gp >> 2][0][gp & 3][n][j]), un = dpp_next(uc, acc[gn >> 2][0][gn & 3][n][j]);
                    up = pv ? up : 0.f; un = nv ? un : 0.f;
                    const float c = w0[j] * up + w1[j] * uc + w2[j] * un + wb[j];
                    r[j] = gelu_f(c) * acc[ai][1][m][n][j]; }
                if (ov) { u32x2 w; w.x = cvt_pk_bf16(r[0], r[1]); w.y = cvt_pk_bf16(r[2], r[3]); *(u32x2*)((char*)O + ((unsigned)tok * (unsigned)(DFF * 2) + (unsigned)oc * 2u)) = w; } }
            __builtin_amdgcn_sched_barrier(0); }
    }
};
__device__ __forceinline__ float2 cmul(float2 a, float2 b) { return make_float2(a.x * b.x - a.y * b.y, a.x * b.y + a.y * b.x); }

__device__ __forceinline__ void p0_mods(const Params& p, LAS unsigned char* lds, const int tid) {
    LAS float* cond = (LAS float*)lds; LAS float* red = (LAS float*)(lds + 36864);
    for (int i = tid; i < NB * D; i += NTHR) { const int b = i >> 10, k = i & 1023; const float c = b == 0 ? p.in[I_CP][k] : p.in[I_CS][(b - 1) * D + k]; cond[i] = c / (1.0f + expf(-c)); }
    __syncthreads();
    float* mods = (float*)(p.ws + WS_MODS);
    for (int item = blockIdx.x; item < 384; item += gridDim.x) {
        const int layer = item / 192, n0 = (item % 192) * 32, cl = tid & 31, ks = tid >> 5;
        const float* w = p.in[I_WADA] + (size_t)layer * D * 6144 + (size_t)(ks * 64) * 6144 + n0 + cl;
        float acc[NB];
#pragma unroll
        for (int b = 0; b < NB; ++b) acc[b] = 0.f;
        for (int k = 0; k < 64; ++k) { const float wv = w[(size_t)k * 6144];
#pragma unroll
            for (int b = 0; b < NB; ++b) acc[b] += cond[b * D + ks * 64 + k] * wv; }
#pragma unroll
        for (int b = 0; b < NB; ++b) red[(ks * 32 + cl) * NB + b] = acc[b];
        __syncthreads();
        if (tid < 288) { const int c2 = tid & 31, b = tid >> 5; float s = 0.f; for (int k2 = 0; k2 < 16; ++k2) s += red[(k2 * 32 + c2) * NB + b];
            mods[(size_t)(layer * NB + b) * 6144 + n0 + c2] = s + p.in[I_BADA][layer * 6144 + n0 + c2]; }
        __syncthreads();
    }
}
struct WDesc { const float* src; bf16_t* dst; int K, N, rows, kind, halfoff; };
__device__ __forceinline__ int wsrc_col(const WDesc& d, int np) { if (d.kind == 0) return col_of(np); const int tile = np >> 8, bj = (np >> 7) & 1, s = np & 127; return (bj ? d.halfoff : 0) + 128 * tile + col_of(s); }
__device__ __forceinline__ void p0_weights(const Params& p, LAS unsigned char* lds, const int tid) {
    LAS float* tile = (LAS float*)lds;
    WDesc ds[7];
    ds[0] = {p.in[I_WGLU], (bf16_t*)(p.ws + WS_WGLU), 1024, 2048, 2048, 1, 1024};
    ds[1] = {p.in[I_WIN], (bf16_t*)(p.ws + WS_WIN), 1024, 5632, 5632, 1, DFF};
    ds[2] = {p.in[I_WIN] + (size_t)1024 * 5632, (bf16_t*)(p.ws + WS_WIN) + (size_t)5632 * 1024, 1024, 5632, 5632, 1, DFF};
    ds[3] = {p.in[I_WOUT], (bf16_t*)(p.ws + WS_WOUT), DFF, 1024, 1024, 0, 0};
    ds[4] = {p.in[I_WOUT] + (size_t)DFF * 1024, (bf16_t*)(p.ws + WS_WOUT) + (size_t)1024 * DFF, DFF, 1024, 1024, 0, 0};
    ds[5] = {p.in[I_WQKV], (bf16_t*)(p.ws + WS_WQKV), 1024, 3072, 3072, 0, 0};
    ds[6] = {p.in[I_WO], (bf16_t*)(p.ws + WS_WO), 1024, 1024, 1024, 0, 0};
    int base = 0;
#pragma unroll
    for (int mi = 0; mi < 7; ++mi) { const WDesc d = ds[mi]; const int tk = d.K / 64, nt = (d.rows / 64) * tk;
        int first = (int)blockIdx.x - base % (int)gridDim.x; if (first < 0) first += gridDim.x;
        for (int it = first; it < nt; it += gridDim.x) { const int n0 = (it / tk) * 64, k0 = (it % tk) * 64;
            const int r = tid & 63; const int sc = wsrc_col(d, n0 + r);
#pragma unroll
            for (int j = 0; j < 8; ++j) { const int kk = (tid >> 6) + 8 * j; tile[r * 65 + kk] = d.src[(size_t)(k0 + kk) * d.N + sc]; }
            __syncthreads();
            { const int r2 = tid >> 3, kq = tid & 7; f32x4 a, b;
#pragma unroll
                for (int e = 0; e < 4; ++e) { a[e] = tile[r2 * 65 + kq * 8 + e]; b[e] = tile[r2 * 65 + kq * 8 + 4 + e]; }
                *(u32x4*)(d.dst + (size_t)(n0 + r2) * d.K + k0 + kq * 8) = pack8(a, b); }
            __syncthreads(); }
        base += nt; }
}
__device__ __forceinline__ void p0_s5tabs(const Params& p, const int tid) {
    const int gtid = blockIdx.x * NTHR + tid, gsz = gridDim.x * NTHR;
    float2* pw = (float2*)(p.ws + WS_PW); float2* bbar = (float2*)(p.ws + WS_BBAR);
    for (int i = gtid; i < 2 * 64 * 65 * 64; i += gsz) { const int pp = i & 63, tau = (i >> 6) % 65, dg = i / (64 * 65); const int idx = dg * 64 + pp;
        const double dt = exp((double)p.in[I_LDT][dg]), zr = (double)p.in[I_LRE][idx] * dt, zi = (double)p.in[I_LIM][idx] * dt; const double mag = exp(zr * tau), ang = zi * tau;
        pw[i] = make_float2((float)(mag * cos(ang)), (float)(mag * sin(ang))); }
    for (int i = gtid; i < 2 * 64 * 64 * 16; i += gsz) { const int idx = i >> 4, dg = idx >> 6;
        const double dt = exp((double)p.in[I_LDT][dg]), lr = p.in[I_LRE][idx], li = p.in[I_LIM][idx], zr = lr * dt, zi = li * dt, mag = exp(zr), abr = mag * cos(zi), abi = mag * sin(zi);
        const double den = lr * lr + li * li, nr = abr - 1.0, ni = abi, fr = (nr * lr + ni * li) / den, fi = (ni * lr - nr * li) / den; const double br = p.in[I_BRE][i], bi = p.in[I_BIM][i];
        bbar[i] = make_float2((float)(fr * br - fi * bi), (float)(fr * bi + fi * br)); }
    float* st = (float*)(p.ws + WS_STATS);
    for (int i = gtid; i < 4 * NTOK * 2; i += gsz) st[i] = 0.f;
}

__device__ __forceinline__ void p1_umat(const Params& p, LAS unsigned char* lds, const int tid) {
    const float* mods = (const float*)(p.ws + WS_MODS); bf16_t* As5 = (bf16_t*)(p.ws + WS_AS5);
    const int ch = (tid & 255) * 4, tk0 = tid >> 8;
    f32x4 x[8];
    int tile = blockIdx.x;
    if (tile < NTOK / 16) {
#pragma unroll
        for (int j = 0; j < 8; ++j) x[j] = *(const f32x4*)(xin_row(p, tile * 16 + j * 2 + tk0) + ch); }
    for (; tile < NTOK / 16; tile += gridDim.x) { const int tok0 = tile * 16, b = tok_b(tok0); const float* m = mods + (size_t)b * 6144;
        const f32x4 sh = *(const f32x4*)(m + ch), sc = *(const f32x4*)(m + D + ch);
#pragma unroll
        for (int j = 0; j < 8; ++j) { const int tk = j * 2 + tk0; f32x4 h; for (int e = 0; e < 4; ++e) h[e] = x[j][e] * (1.0f + sc[e]) + sh[e];
            u32x2 w; w.x = cvt_pk_bf16(h[0], h[1]); w.y = cvt_pk_bf16(h[2], h[3]); *(LAS u32x2*)(lds + (tk * 1024 + ch) * 2) = w; }
        const int nxt = tile + gridDim.x;
        if (nxt < NTOK / 16) {
#pragma unroll
            for (int j = 0; j < 8; ++j) x[j] = *(const f32x4*)(xin_row(p, nxt * 16 + j * 2 + tk0) + ch); }
        __syncthreads();
        { const int g = tid >> 3, c = tile >> 2;
#pragma unroll
            for (int j = 0; j < 4; ++j) { const int q = (tid & 7) * 4 + j, tk = q >> 1, half = q & 1, s = (tile & 3) * 16 + tk;
                *(u32x4*)(As5 + ((size_t)(g * 768 + c) * 1280 + s * 16 + half * 8)) = *(const LAS u32x4*)(lds + (tk * 1024 + g * 16 + half * 8) * 2); } }
        __syncthreads(); }
}
__device__ __forceinline__ void p1_ktab(const Params& p, const int tid) {
    const int lane = tid & 63, w = tid >> 6, li = lane & 15, lk = lane >> 4;
    const float2* pw = (const float2*)(p.ws + WS_PW); const float2* bbar = (const float2*)(p.ws + WS_BBAR); float* ktab = (float*)(p.ws + WS_KTAB);
    const float* cre = p.in[I_CRE]; const float* cim = p.in[I_CIM];
    for (int item = blockIdx.x; item < 256; item += gridDim.x) { const int dg = item >> 1, th = item & 1;
        float are[2][16], aim[2][16];
#pragma unroll
        for (int tt = 0; tt < 2; ++tt)
#pragma unroll
            for (int ks = 0; ks < 16; ++ks) { const float2 v = pw[(size_t)(dg * 65 + th * 32 + tt * 16 + li) * 64 + 4 * ks + lk]; are[tt][ks] = v.x; aim[tt][ks] = -v.y; }
#pragma unroll
        for (int hh = 0; hh < 2; ++hh) { const int h = 2 * w + hh; f32x4 acc[2] = {(f32x4){0.f, 0.f, 0.f, 0.f}, (f32x4){0.f, 0.f, 0.f, 0.f}};
#pragma unroll
            for (int ks = 0; ks < 16; ++ks) { const int pp = 4 * ks + lk; const float2 c = make_float2(cre[(size_t)(dg * 16 + h) * 64 + pp], cim[(size_t)(dg * 16 + h) * 64 + pp]);
                const float2 wv = cmul(c, bbar[((size_t)dg * 64 + pp) * 16 + li]);
#pragma unroll
                for (int tt = 0; tt < 2; ++tt) { acc[tt] = __builtin_amdgcn_mfma_f32_16x16x4f32(are[tt][ks], wv.x, acc[tt], 0, 0, 0); acc[tt] = __builtin_amdgcn_mfma_f32_16x16x4f32(aim[tt][ks], wv.y, acc[tt], 0, 0, 0); } }
#pragma unroll
            for (int tt = 0; tt < 2; ++tt)
#pragma unroll
                for (int r = 0; r < 4; ++r) { const int tau = th * 32 + tt * 16 + 4 * lk + r; ktab[((size_t)(dg * 64 + tau) * 16 + h) * 16 + li] = acc[tt][r]; } } }
}
__device__ __forceinline__ void p1_tables(const Params& p, const int tid, const int sub = 0) {
    const int gtid = blockIdx.x * NTHR + tid, gsz = gridDim.x * NTHR;
    const float2* pw = (const float2*)(p.ws + WS_PW); const float2* bbar = (const float2*)(p.ws + WS_BBAR);
    const float* cre = p.in[I_CRE]; const float* cim = p.in[I_CIM];
    bf16_t* bsend = (bf16_t*)(p.ws + WS_BSEND);
    if (sub == 0 || sub == 3) for (int i = gtid; i < 64 * 256 * 128; i += gsz) { const int oct = i & 127, np = (i >> 7) & 255, g = i >> 15, s = oct >> 1, half = oct & 1, col = col_of(np), seg = col >> 6, pp = col & 63, dir = seg >> 1, im = seg & 1;
        const float2 pv = pw[(size_t)((dir * 64 + g) * 65 + (dir == 0 ? 63 - s : s)) * 64 + pp]; const float2* bb = bbar + ((size_t)(dir * 64 + g) * 64 + pp) * 16 + half * 8; f32x4 a, b;
#pragma unroll
        for (int e = 0; e < 4; ++e) { const float2 x = cmul(pv, bb[e]), y = cmul(pv, bb[4 + e]); a[e] = im ? x.y : x.x; b[e] = im ? y.y : y.x; }
        *(u32x4*)(bsend + ((size_t)(g * 256 + np) * 1024 + s * 16 + half * 8)) = pack8(a, b); }
    bf16_t* bs5 = (bf16_t*)(p.ws + WS_BS5);
    if (sub == 0 || sub == 4) for (int i = gtid; i < 64 * 1024 * 32; i += gsz) { const int oct = i & 31, np = (i >> 5) & 1023, g = i >> 15, col = col_of(np), t = col >> 4, h = col & 15, seg = oct >> 3, p0 = (oct & 7) * 8, dir = seg >> 1, im = seg & 1;
        const float* cr = cre + (size_t)((dir * 64 + g) * 16 + h) * 64 + p0; const float* ci = cim + (size_t)((dir * 64 + g) * 16 + h) * 64 + p0; const float2* pwr = pw + (size_t)((dir * 64 + g) * 65 + (dir == 0 ? t + 1 : 64 - t)) * 64 + p0; f32x4 a, b;
#pragma unroll
        for (int e = 0; e < 4; ++e) { const float2 x = cmul(make_float2(cr[e], ci[e]), pwr[e]), y = cmul(make_float2(cr[4 + e], ci[4 + e]), pwr[4 + e]); a[e] = im ? -x.y : x.x; b[e] = im ? -y.y : y.x; }
        *(u32x4*)(bs5 + ((size_t)(g * 1024 + np) * 1280 + 1024 + oct * 8)) = pack8(a, b); }
    const float* mods = (const float*)(p.ws + WS_MODS); float* gam = (float*)(p.ws + WS_GAM);
    if (sub == 0 || sub == 5) for (int i = gtid; i < 3 * NB * D; i += gsz) { const int n = i & 1023, b = (i >> 10) % NB, j = i / (NB * D); const int layer = j == 0 ? 0 : 1, sco = j == 1 ? 1 : 4;
        gam[i] = p.in[I_LNG][j * D + n] * (1.0f + mods[(size_t)(layer * NB + b) * 6144 + sco * D + n]); }
}
__device__ __forceinline__ void p1_cvec(const Params& p, LAS unsigned char* lds, const int tid) {
    LAS float* gpr = (LAS float*)lds; LAS float* bpr = (LAS float*)(lds + 36864);
    const int lane = tid & 63, w = tid >> 6, li = lane & 15, lk = lane >> 4; const float* mods = (const float*)(p.ws + WS_MODS); float* cv = (float*)(p.ws + WS_CVEC);
    int last_sel = -1;
    for (int item = blockIdx.x; item < 112; item += gridDim.x) {
        const int t0 = item * 8, sel = t0 < 352 ? 0 : (t0 < 544 ? 1 : 2), tl = t0 + w - (sel == 0 ? 0 : (sel == 1 ? 352 : 544));
        const int N = sel == 1 ? 3072 : 5632, layer = sel == 0 ? 0 : 1, lnj = sel, sco = sel == 1 ? 1 : 4, sho = sel == 1 ? 0 : 3;
        const float* W = sel == 0 ? p.in[I_WIN] : (sel == 1 ? p.in[I_WQKV] : p.in[I_WIN] + (size_t)1024 * 5632);
        const float* bias = sel == 0 ? p.in[I_BIN] : (sel == 1 ? p.in[I_BQKV] : p.in[I_BIN] + 5632);
        float* c1 = cv + (sel == 0 ? CV_IN0 : (sel == 1 ? CV_QKV : CV_IN1)); float* c2 = c1 + NB * N;
        if (sel != last_sel) { __syncthreads();
            for (int i = tid; i < NB * D; i += NTHR) { const int b = i >> 10, k = i & 1023; const float* m = mods + (size_t)(layer * NB + b) * 6144; const float sc = m[sco * D + k], sh = m[sho * D + k];
                gpr[i] = p.in[I_LNG][lnj * D + k] * (1.0f + sc); bpr[i] = p.in[I_LNB][lnj * D + k] * (1.0f + sc) + sh; }
            __syncthreads(); last_sel = sel; }
        const int n0 = tl * 16; const float* wp = W + (size_t)lk * N + n0 + li; const int brow = li < NB ? li : 0; const float msk = li < NB ? 1.0f : 0.0f;
        f32x4 d1 = (f32x4){0.f, 0.f, 0.f, 0.f}, d2 = d1;
#pragma unroll 8
        for (int ks = 0; ks < 256; ++ks) { const float bv = wp[(size_t)(4 * ks) * N]; const float a1 = gpr[brow * D + 4 * ks + lk] * msk, a2 = bpr[brow * D + 4 * ks + lk] * msk;
            d1 = __builtin_amdgcn_mfma_f32_16x16x4f32(a1, bv, d1, 0, 0, 0); d2 = __builtin_amdgcn_mfma_f32_16x16x4f32(a2, bv, d2, 0, 0, 0); }
#pragma unroll
        for (int r = 0; r < 4; ++r) { const int b = 4 * lk + r; if (b < NB) { c1[(size_t)b * N + n0 + li] = d1[r]; c2[(size_t)b * N + n0 + li] = d2[r] + bias[n0 + li]; } }
    }
}
__device__ __forceinline__ void p2_tbuild(const Params& p, const int tid) {
    const int gtid = blockIdx.x * NTHR + tid, gsz = gridDim.x * NTHR;
    const float* ktab = (const float*)(p.ws + WS_KTAB); bf16_t* bs5 = (bf16_t*)(p.ws + WS_BS5); const float* sd = p.in[I_SD];
    for (int i0 = gtid; i0 < 64 * 1024 * 128; i0 += 8 * gsz) {
        f32x4 a[8], b[8], c[8], d[8]; unsigned dst[8]; int dd[8]; float dv[8];
#pragma unroll
        for (int e = 0; e < 8; ++e) { int i = i0 + e * gsz; i = i < 64 * 1024 * 128 ? i : i0; const int oct = i & 127, np = (i >> 7) & 1023, g = i >> 17, s = oct >> 1, half = oct & 1, col = col_of(np), t = col >> 4, h = col & 15;
            const int dir = t >= s ? 0 : 1, tau = t >= s ? t - s : s - t; const float* kp = ktab + ((size_t)((dir * 64 + g) * 64 + tau) * 256 + h * 16 + half * 8);
            a[e] = *(const f32x4*)kp; b[e] = *(const f32x4*)(kp + 4);
            dd[e] = -1; dv[e] = 0.f; c[e] = (f32x4){0.f, 0.f, 0.f, 0.f}; d[e] = c[e];
            if (t == s) { const float* kb = ktab + ((size_t)((64 + g) * 64) * 256 + h * 16 + half * 8); c[e] = *(const f32x4*)kb; d[e] = *(const f32x4*)(kb + 4); dd[e] = h - half * 8; dv[e] = sd[g * 16 + h]; }
            dst[e] = (unsigned)(g * 1024 + np) * 2560u + (unsigned)(s * 16 + half * 8) * 2u; }
#pragma unroll
        for (int e = 0; e < 8; ++e) { f32x4 x = a[e] + c[e], y = b[e] + d[e];
#pragma unroll
            for (int q = 0; q < 4; ++q) { if (dd[e] == q) x[q] += dv[e]; if (dd[e] == 4 + q) y[q] += dv[e]; }
            *(u32x4*)((char*)bs5 + dst[e]) = pack8(x, y); }
    }
}
__device__ __forceinline__ void p3_carry(const Params& p, const int tid) {
    const int gtid = blockIdx.x * NTHR + tid, gsz = gridDim.x * NTHR;
    const float2* pw = (const float2*)(p.ws + WS_PW); const float* send = (const float*)(p.ws + WS_SEND); bf16_t* As5 = (bf16_t*)(p.ws + WS_AS5);
    for (int i = gtid; i < 2 * 64 * NB * 64; i += gsz) { const int pp = i & 63, rest = i >> 6, b = rest % NB, r2 = rest / NB, g = r2 & 63, dir = r2 >> 6;
        const float2 a64 = pw[(size_t)((dir * 64 + g) * 65 + 64) * 64 + pp]; const int c0 = seq_start(b) / 64, nch = seq_len(b) / 64;
        float2 car = make_float2(0.f, 0.f);
        for (int i0 = 0; i0 < nch; i0 += 8) { float2 sv[8];
#pragma unroll
            for (int e = 0; e < 8; ++e) { const int c = c0 + (dir == 0 ? i0 + e : nch - 1 - i0 - e); const float* sp = send + (size_t)(g * 768 + c) * 256 + dir * 128 + pp; sv[e] = make_float2(sp[0], sp[64]); }
#pragma unroll
            for (int e = 0; e < 8; ++e) { const int c = c0 + (dir == 0 ? i0 + e : nch - 1 - i0 - e); bf16_t* ap = As5 + (size_t)(g * 768 + c) * 1280 + 1024 + dir * 128 + pp; ap[0] = f2bf(car.x); ap[64] = f2bf(car.y);
                const float2 n = cmul(a64, car); car = make_float2(n.x + sv[e].x, n.y + sv[e].y); } } }
}
template <int OFF> __device__ __forceinline__ s16x4 tr_read(unsigned addr) { s16x4 r; asm volatile("ds_read_b64_tr_b16 %0, %1 offset:%2" : "=&v"(r) : "v"(addr), "i"(OFF) : "memory"); return r; }
constexpr int NA_K = 0, NA_V = 9 * 8192, NA_BIAS = 18 * 8192;
__device__ __forceinline__ void p9_attn(const Params& p, LAS unsigned char* lds, const int tid) {
    const int wid = tid >> 6, lane = tid & 63, l15 = lane & 15, g = lane >> 4, qr = wid >> 2, j = wid & 3;
    const bf16_t* qkv = (const bf16_t*)(p.ws + WS_QKV); bf16_t* o = (bf16_t*)(p.ws + WS_O);
    const int u0 = j == 0 ? 0 : (j == 1 ? 8 : (j == 2 ? 24 : 32));
    const int c = 16 * j + l15; int cs = c - 8; cs = cs < 0 ? 0 : (cs > 48 ? 48 : cs);
    LAS float* bias = (LAS float*)(lds + NA_BIAS);
    for (int item = blockIdx.x; item < 768; item += gridDim.x) {
        const int h = item & 15, rr = item >> 4; int b, R0; if (rr < 16) { b = 0; R0 = rr * 16; } else { b = 1 + ((rr - 16) >> 2); R0 = ((rr - 16) & 3) * 16; }
        const int s0 = seq_start(b), nrows = seq_len(b) / 64;
        __syncthreads();
        for (int i = tid; i < 465; i += NTHR) bias[i] = p.in[I_RPB][h * 465 + i];
        const bf16_t* kbase = qkv + 1024 + h * 64; const bf16_t* vbase = qkv + 2048 + h * 64;
        const int ltok = tid >> 3, lch = tid & 7; const unsigned lds_st = (unsigned)(ltok * 128 + ((lch ^ (ltok & 7)) * 16));
        int have_hi;
        {
            int lo = R0 - 4; lo = lo < 0 ? 0 : (lo > nrows - 8 ? nrows - 8 : lo); int hi = R0 + 1 - 4; hi = hi < 0 ? 0 : (hi > nrows - 8 ? nrows - 8 : hi); hi += 7;
            for (int kr = lo; kr <= hi; ++kr) { const size_t tk = (size_t)(s0 + kr * 64 + ltok) * 3072 + lch * 8; const u32x4 kv = *(const u32x4*)(kbase + tk), vv = *(const u32x4*)(vbase + tk);
                const unsigned so = (unsigned)((kr % 9) * 8192) + lds_st; *(LAS u32x4*)(lds + NA_K + so) = kv; *(LAS u32x4*)(lds + NA_V + so) = vv; }
            have_hi = hi; }
        __syncthreads();
        for (int pp = 0; pp < 8; ++pp) {
            const int r0 = R0 + 2 * pp;
            u32x4 nk[2], nv[2]; int nnew = 0, nlo = 0;
            if (pp < 7) { int hi = r0 + 3 - 4; hi = hi < 0 ? 0 : (hi > nrows - 8 ? nrows - 8 : hi); hi += 7; nlo = have_hi + 1; nnew = hi - have_hi;
#pragma unroll
                for (int e = 0; e < 2; ++e) if (e < nnew) { const size_t tk = (size_t)(s0 + (nlo + e) * 64 + ltok) * 3072 + lch * 8; nk[e] = *(const u32x4*)(kbase + tk); nv[e] = *(const u32x4*)(vbase + tk); } }
            const int r = r0 + qr; int rs = r - 4; rs = rs < 0 ? 0 : (rs > nrows - 8 ? nrows - 8 : rs);
            const size_t tq = (size_t)(s0 + r * 64 + c);
            bf16x8 qf[2]; qf[0] = *(const bf16x8*)(qkv + tq * 3072 + h * 64 + g * 8); qf[1] = *(const bf16x8*)(qkv + tq * 3072 + h * 64 + 32 + g * 8);
            f32x4 S[8][2];
#pragma unroll
            for (int k8 = 0; k8 < 8; ++k8) { const unsigned slot = (unsigned)(((rs + k8) % 9) * 8192);
#pragma unroll
                for (int tl = 0; tl < 2; ++tl) { const int col = u0 + 16 * tl + l15; f32x4 a = (f32x4){0.f, 0.f, 0.f, 0.f};
#pragma unroll
                    for (int ks = 0; ks < 2; ++ks) { const bf16x8 kf = *(const LAS bf16x8*)(lds + NA_K + slot + col * 128 + (((g + 4 * ks) ^ (col & 7)) * 16)); a = __builtin_amdgcn_mfma_f32_16x16x32_bf16(kf, qf[ks], a, 0, 0, 0); }
                    S[k8][tl] = a; } }
            float mx = -3.0e38f;
#pragma unroll
            for (int k8 = 0; k8 < 8; ++k8)
#pragma unroll
                for (int tl = 0; tl < 2; ++tl)
#pragma unroll
                    for (int e = 0; e < 4; ++e) { const int kc = u0 + 16 * tl + 4 * g + e; const bool ok = kc >= cs && kc <= cs + 15; int bi = (rs + k8 - r + 7) * 31 + (kc - c + 15); bi = ok ? bi : 0;
                        const float sv = ok ? S[k8][tl][e] + bias[bi] : -3.0e38f; S[k8][tl][e] = sv; mx = fmaxf(mx, sv); }
            mx = fmaxf(mx, __shfl_xor(mx, 16)); mx = fmaxf(mx, __shfl_xor(mx, 32));
            float sum = 0.f;
#pragma unroll
            for (int k8 = 0; k8 < 8; ++k8)
#pragma unroll
                for (int tl = 0; tl < 2; ++tl)
#pragma unroll
                    for (int e = 0; e < 4; ++e) { const float pe = __expf(S[k8][tl][e] - mx); S[k8][tl][e] = pe; sum += pe; }
            sum += __shfl_xor(sum, 16); sum += __shfl_xor(sum, 32);
            const float inv = 1.0f / sum;
            f32x4 O[4];
#pragma unroll
            for (int dt = 0; dt < 4; ++dt) O[dt] = (f32x4){0.f, 0.f, 0.f, 0.f};
#pragma unroll
            for (int k8 = 0; k8 < 8; ++k8) { const unsigned slot = (unsigned)(((rs + k8) % 9) * 8192);
                const u32x4 pk = pack8(S[k8][0] * inv, S[k8][1] * inv); bf16x8 pf; __builtin_memcpy(&pf, &pk, 16);
                const int col0 = u0 + 4 * g + (l15 >> 2), col1 = col0 + 16;
#pragma unroll
                for (int dt = 0; dt < 4; ++dt) { const int ch = dt * 2 + ((l15 & 3) >> 1);
                    const unsigned a0 = (unsigned)(NA_V) + slot + (unsigned)(col0 * 128 + ((ch ^ (col0 & 7)) * 16) + (l15 & 1) * 8), a1 = (unsigned)(NA_V) + slot + (unsigned)(col1 * 128 + ((ch ^ (col1 & 7)) * 16) + (l15 & 1) * 8);
                    const s16x4 v0 = tr_read<0>(a0), v1 = tr_read<0>(a1);
                    asm volatile("s_waitcnt lgkmcnt(0)" ::: "memory"); __builtin_amdgcn_sched_barrier(0);
                    const bf16x8 vf = (bf16x8){v0[0], v0[1], v0[2], v0[3], v1[0], v1[1], v1[2], v1[3]};
                    O[dt] = __builtin_amdgcn_mfma_f32_16x16x32_bf16(vf, pf, O[dt], 0, 0, 0); } }
#pragma unroll
            for (int dt = 0; dt < 4; ++dt) { u32x2 w; w.x = cvt_pk_bf16(O[dt][0], O[dt][1]); w.y = cvt_pk_bf16(O[dt][2], O[dt][3]); *(u32x2*)(o + tq * D + h * 64 + dt * 16 + 4 * g) = w; }
            __syncthreads();
#pragma unroll
            for (int e = 0; e < 2; ++e) if (e < nnew) { const unsigned so = (unsigned)(((nlo + e) % 9) * 8192) + lds_st; *(LAS u32x4*)(lds + NA_K + so) = nk[e]; *(LAS u32x4*)(lds + NA_V + so) = nv[e]; }
            have_hi += nnew;
            __syncthreads();
        }
    }
}
template <bool DRY> __device__ __forceinline__ void p13_final_t(const Params& p, const int tid) {
    const int wv = blockIdx.x * (NTHR / 64) + (tid >> 6), nwv = gridDim.x * (NTHR / 64), lane = tid & 63;
    const float* lng = p.in[I_LNG] + 3 * D; const float* lnb = p.in[I_LNB] + 3 * D;
    for (int row = wv; row < NTOK; row += nwv) { float* v = p.out + (size_t)row * D; f32x4 x[4];
#pragma unroll
        for (int q = 0; q < 4; ++q) x[q] = *(const f32x4*)(v + q * 256 + lane * 4);
        float s = 0.f;
#pragma unroll
        for (int q = 0; q < 4; ++q) s += (x[q][0] + x[q][1]) + (x[q][2] + x[q][3]);
        for (int o = 32; o >= 1; o >>= 1) s += __shfl_xor(s, o);
        const float mean = s * (1.0f / D); float q2 = 0.f;
#pragma unroll
        for (int q = 0; q < 4; ++q) { const f32x4 d = x[q] - mean; q2 += (d[0] * d[0] + d[1] * d[1]) + (d[2] * d[2] + d[3] * d[3]); }
        for (int o = 32; o >= 1; o >>= 1) q2 += __shfl_xor(q2, o);
        const float rstd = rsqrtf(q2 * (1.0f / D) + LN_EPS);
#pragma unroll
        for (int q = 0; q < 4; ++q) { const int n = q * 256 + lane * 4; const f32x4 gg = *(const f32x4*)(lng + n), bb = *(const f32x4*)(lnb + n); const f32x4 ov = (x[q] - mean) * rstd * gg + bb; if (!DRY || ov[0] == 1.2345e30f) *(f32x4*)(v + n) = ov; } }
}
__device__ __forceinline__ void p13_final(const Params& p, const int tid) { p13_final_t<false>(p, tid); }
__device__ __forceinline__ void p13_final_dry(const Params& p, const int tid) { p13_final_t<true>(p, tid); }
__device__ __forceinline__ void ph_gemm_send(const Params& p, LAS unsigned char* lds, const int tid) {
    SchedS5 S; S.o.init(192, 1, gridDim.x, blockIdx.x); S.A = (const char*)(p.ws + WS_AS5); S.B = (const char*)(p.ws + WS_BSEND); S.b_gstride = (size_t)256 * 2048; S.b_rs = 2048;
    const GShape g{16, 2560u, 32u, 2048u}; const EpiSend E{(float*)(p.ws + WS_SEND)};
    gemm_phase(lds, g, S, E, tid);
}
__device__ __forceinline__ void ph_gemm_s5(const Params& p, LAS unsigned char* lds, const int tid) {
    SchedS5 S; S.o.init(192, 4, gridDim.x, blockIdx.x); S.A = (const char*)(p.ws + WS_AS5); S.B = (const char*)(p.ws + WS_BS5); S.b_gstride = (size_t)1024 * 2560; S.b_rs = 2560;
    const GShape g{20, 2560u, 32u, 2560u}; const EpiS5 E{(bf16_t*)(p.ws + WS_YG)};
    gemm_phase(lds, g, S, E, tid);
}
__device__ __forceinline__ void ph_gemm_glu(const Params& p, LAS unsigned char* lds, const int tid, const bool dry = false) {
    SchedPlain S; S.o.init(192, 8, gridDim.x, blockIdx.x); S.A = (const char*)(p.ws + WS_YG); S.B = (const char*)(p.ws + WS_WGLU); S.a_rs = 32; S.b_rs = 2048;
    const GShape g{16, 32u, (unsigned)(NTOK * 32), 2048u};
    const EpiGlu E{p.in[I_XP], p.in[I_XS], p.out, p.in[I_BGLU], (const float*)(p.ws + WS_MODS), (const float*)(p.ws + WS_GAM), (float*)(p.ws + WS_STATS), (bf16_t*)(p.ws + WS_APR), dry};
    gemm_phase(lds, g, S, E, tid);
}
__device__ __forceinline__ void ph_gemm_ffn_in(const Params& p, LAS unsigned char* lds, const int tid, int layer) {
    SchedFfnIn S; S.o.init(FFN_UNITS_M, 22, gridDim.x, blockIdx.x); S.A = (const char*)(p.ws + (layer == 0 ? WS_APR : WS_APR3)); S.B = (const char*)(p.ws + WS_WIN) + (size_t)layer * 5632 * 2048;
    const GShape g{16, 2048u, 32u, 2048u};
    const float* c1 = (const float*)(p.ws + WS_CVEC) + (layer == 0 ? CV_IN0 : CV_IN1);
    const EpiFfnIn E{c1, c1 + NB * 5632, (const float*)(p.ws + WS_STATS) + (size_t)(layer == 0 ? 0 : 2) * NTOK * 2, p.in[I_CW] + (size_t)layer * 3 * DFF, p.in[I_CB] + (size_t)layer * DFF, (bf16_t*)(p.ws + (layer == 0 ? WS_A0 : WS_A1))};
    gemm_phase(lds, g, S, E, tid);
}
__device__ __forceinline__ void ph_gemm_ffn_out(const Params& p, LAS unsigned char* lds, const int tid, int layer, const bool dry = false) {
    SchedPlain S; S.o.init(192, 4, gridDim.x, blockIdx.x); S.A = (const char*)(p.ws + (layer == 0 ? WS_A0 : WS_A1)); S.B = (const char*)(p.ws + WS_WOUT) + (size_t)layer * 1024 * 5632; S.a_rs = 5632; S.b_rs = 5632;
    const GShape g{44, 5632u, 32u, 5632u};
    const float* mods_l = (const float*)(p.ws + WS_MODS) + (size_t)layer * NB * 6144; float* st = (float*)(p.ws + WS_STATS);
    const EpiOut E{p.out, p.in[I_BOUT] + layer * D, p.in[I_LNG] + (layer * 2) * D, p.in[I_LNB] + (layer * 2) * D, mods_l + 5 * D, layer == 0 ? (const float*)(p.ws + WS_GAM) + NB * D : nullptr,
                   st + (size_t)(layer == 0 ? 0 : 2) * NTOK * 2, layer == 0 ? st + (size_t)1 * NTOK * 2 : nullptr, layer == 0 ? (bf16_t*)(p.ws + WS_APR) : nullptr, dry};
    gemm_phase(lds, g, S, E, tid);
}
__device__ __forceinline__ void ph_gemm_qkv(const Params& p, LAS unsigned char* lds, const int tid) {
    SchedPlain S; S.o.init(192, 12, gridDim.x, blockIdx.x); S.A = (const char*)(p.ws + WS_APR); S.B = (const char*)(p.ws + WS_WQKV); S.a_rs = 2048; S.b_rs = 2048;
    const GShape g{16, 2048u, 32u, 2048u}; const float* c1 = (const float*)(p.ws + WS_CVEC) + CV_QKV;
    const EpiQkv E{c1, c1 + NB * 3072, (const float*)(p.ws + WS_STATS) + (size_t)1 * NTOK * 2, (bf16_t*)(p.ws + WS_QKV)};
    gemm_phase(lds, g, S, E, tid);
}
__device__ __forceinline__ void ph_gemm_wo(const Params& p, LAS unsigned char* lds, const int tid, const bool dry = false) {
    SchedPlain S; S.o.init(192, 4, gridDim.x, blockIdx.x); S.A = (const char*)(p.ws + WS_O); S.B = (const char*)(p.ws + WS_WO); S.a_rs = 2048; S.b_rs = 2048;
    const GShape g{16, 2048u, 32u, 2048u};
    const float* mods_l = (const float*)(p.ws + WS_MODS) + (size_t)1 * NB * 6144; float* st = (float*)(p.ws + WS_STATS);
    const EpiOut E{p.out, p.in[I_BO], p.in[I_LNG] + 1 * D, p.in[I_LNB] + 1 * D, mods_l + 2 * D, (const float*)(p.ws + WS_GAM) + 2 * NB * D, st + (size_t)1 * NTOK * 2, st + (size_t)2 * NTOK * 2, (bf16_t*)(p.ws + WS_APR3), dry};
    gemm_phase(lds, g, S, E, tid);
}

#define XB_TMO      128
#define XB_XCNT(j)  (256  + 64 * (j))
#define XB_XSUB(j)  (1280 + 64 * (j))
#define XB_XGEN(j)  (2304 + 64 * (j))
#define XB_TOP      3328
#define XB_TOPGEN   3392
#define XCD_BAR_WORDS 3456
#define XB_SPIN_CAP (1u << 18)
__device__ __forceinline__ unsigned xb_ld(unsigned* p)              { return __hip_atomic_load(p, __ATOMIC_RELAXED, __HIP_MEMORY_SCOPE_AGENT); }
__device__ __forceinline__ unsigned xb_add(unsigned* p, unsigned v) { return __hip_atomic_fetch_add(p, v, __ATOMIC_RELAXED, __HIP_MEMORY_SCOPE_AGENT); }
__device__ __forceinline__ unsigned xb_xcc_id() { return (unsigned)__builtin_amdgcn_s_getreg((3 << 11) | 20) & 0xFu; }
#define XB_SPIN(cond, bar) do { unsigned _sp = 0; while (cond) { __builtin_amdgcn_s_sleep(1); \
    if ((++_sp & 255u) == 0u) { if (xb_ld(&(bar)[XB_TMO])) break; if (_sp > XB_SPIN_CAP) { atomicAdd(&(bar)[XB_TMO], 1u); break; } } } } while (0)
struct XcdBarrier { unsigned* bar; unsigned x; volatile LAS unsigned* st; int wid0; };
__device__ __forceinline__ XcdBarrier xcd_barrier_post(unsigned* bar, volatile LAS unsigned* st, const int wid0) {
    XcdBarrier b; b.bar = bar; b.x = xb_xcc_id(); b.st = st; b.wid0 = wid0;
    if (wid0 == 0 && lane_id_asm() == 0) (void)xb_add(&bar[XB_XCNT(b.x)], 1u);
    return b;
}
__device__ __forceinline__ void xcd_barrier_complete(unsigned* bar, unsigned x, unsigned& nloc, unsigned& nx) {
    const unsigned G = gridDim.x * gridDim.y * gridDim.z;
    unsigned sum, cnt, mine, sp = 0u;
    for (;;) {
        sum = 0u; cnt = 0u; mine = 0u;
#pragma unroll
        for (unsigned j = 0; j < 16; ++j) { const unsigned c = xb_ld(&bar[XB_XCNT(j)]); sum += c; cnt += (c > 0u) ? 1u : 0u; mine = (j == x) ? c : mine; }
        if (sum == G) break;
        __builtin_amdgcn_s_sleep(1);
        if ((++sp & 255u) == 0u) { if (xb_ld(&bar[XB_TMO])) break; if (sp > XB_SPIN_CAP) { atomicAdd(&bar[XB_TMO], 1u); break; } }
    }
    nloc = mine > 0u ? mine : 1u; nx = cnt > 0u ? cnt : 1u;
}
__device__ __forceinline__ void xcd_barrier(const XcdBarrier& b) {
    asm volatile("s_waitcnt vmcnt(0)" ::: "memory");
    __syncthreads();
    if (b.wid0 == 0 && lane_id_asm() == 0) {
        unsigned* bar = b.bar;
        __builtin_amdgcn_s_waitcnt(0);
        unsigned nloc = b.st[0], nx = b.st[1];
        if (nloc == 0u) { xcd_barrier_complete(bar, b.x, nloc, nx); b.st[0] = nloc; b.st[1] = nx; }
        const unsigned old = xb_add(&bar[XB_XSUB(b.x)], 1u);
        const unsigned gen = old / nloc;
        if (old + 1u == (gen + 1u) * nloc) {
            __builtin_amdgcn_fence(__ATOMIC_RELEASE, "agent");
            asm volatile("s_waitcnt vmcnt(0)" ::: "memory");
            const unsigned og = xb_add(&bar[XB_TOP], 1u);
            const unsigned tg = og / nx;
            if (og + 1u == (tg + 1u) * nx) xb_add(&bar[XB_TOPGEN], 1u);
            else XB_SPIN(xb_ld(&bar[XB_TOPGEN]) == tg, bar);
            __builtin_amdgcn_fence(__ATOMIC_ACQUIRE, "agent");
            xb_add(&bar[XB_XGEN(b.x)], 1u);
            asm volatile("s_waitcnt vmcnt(0)" ::: "memory");
        } else {
            XB_SPIN(xb_ld(&bar[XB_XGEN(b.x)]) == gen, bar);
            __builtin_amdgcn_fence(__ATOMIC_ACQUIRE, "agent");
            asm volatile("s_waitcnt vmcnt(0)" ::: "memory");
        }
    }
    __syncthreads();
}

constexpr int LDS_BYTES = 152 * 1024, LDS_MISC = 150 * 1024;
constexpr int N_PHASES = 14;
__global__ void __launch_bounds__(NTHR, 2) k_fwd(Params p, int lo, int hi, int flags) {
    extern __shared__ __attribute__((aligned(16))) unsigned char lds_raw[];
    LAS unsigned char* lds = (LAS unsigned char*)lds_raw;
    volatile LAS unsigned* misc = (volatile LAS unsigned*)(lds + LDS_MISC);
    const int wid0 = __builtin_amdgcn_readfirstlane((int)threadIdx.x >> 6);
    if (threadIdx.x < 4) misc[threadIdx.x] = 0u;
    __syncthreads();
    XcdBarrier bar; bar.bar = (unsigned*)(p.ws + WS_CTL); bar.x = 0; bar.st = misc; bar.wid0 = wid0;
    const bool multi = (hi - lo) > 1; const bool dryf = (flags & 1) != 0; const int sub = (flags >> 8) & 0xff;
    if (multi) bar = xcd_barrier_post((unsigned*)(p.ws + WS_CTL), misc, wid0);
#define PH(k) (lo <= (k) && (k) < hi)
#define SEAM(k) do { if (PH(k) && PH((k) + 1)) { if ((k) == 0) cg::this_grid().sync(); else xcd_barrier(bar); } } while (0)
#define TID (wid0 * 64 + lane_id_asm())
#ifndef MK_DUP
#define MK_DUP (-1)
#endif
#define DUPB(k, body) do { if (MK_DUP == (k) && PH(k)) { body; xcd_barrier(bar); } } while (0)
    DUPB(0, ({ const int tid = TID; p0_mods(p, lds, tid); __syncthreads(); p0_weights(p, lds, tid); p0_s5tabs(p, tid); }));
    if (PH(0)) { const int tid = TID; if (sub == 0 || sub == 1) p0_mods(p, lds, tid); __syncthreads(); if (sub == 0 || sub == 2) p0_weights(p, lds, tid); if (sub == 0 || sub == 3) p0_s5tabs(p, tid); } SEAM(0);
    DUPB(1, ({ const int tid = TID; p1_umat(p, lds, tid); p1_tables(p, tid); __syncthreads(); p1_cvec(p, lds, tid); }));
    if (PH(1)) { const int tid = TID; if (sub == 0 || sub == 1) p1_umat(p, lds, tid); if (sub == 0 || sub == 2) p1_ktab(p, tid); if (sub != 1 && sub != 2 && sub != 6) p1_tables(p, tid, sub); __syncthreads(); if (sub == 0 || sub == 6) p1_cvec(p, lds, tid); } SEAM(1);
    DUPB(2, ({ const int tid = TID; ph_gemm_send(p, lds, tid); p2_tbuild(p, tid); }));
    if (PH(2)) { const int tid = TID; if (sub == 0 || sub == 1) ph_gemm_send(p, lds, tid); if (sub == 0 || sub == 2) p2_tbuild(p, tid); } SEAM(2);
    DUPB(3, p3_carry(p, TID));
    if (PH(3)) { p3_carry(p, TID); } SEAM(3);
    DUPB(4, ph_gemm_s5(p, lds, TID));
    if (PH(4)) { ph_gemm_s5(p, lds, TID); } SEAM(4);
    DUPB(5, ph_gemm_glu(p, lds, TID, true));
    if (PH(5)) { ph_gemm_glu(p, lds, TID, dryf); } SEAM(5);
    DUPB(6, ph_gemm_ffn_in(p, lds, TID, 0));
    if (PH(6)) { ph_gemm_ffn_in(p, lds, TID, 0); } SEAM(6);
    DUPB(7, ph_gemm_ffn_out(p, lds, TID, 0, true));
    if (PH(7)) { ph_gemm_ffn_out(p, lds, TID, 0, dryf); } SEAM(7);
    DUPB(8, ph_gemm_qkv(p, lds, TID));
    if (PH(8)) { ph_gemm_qkv(p, lds, TID); } SEAM(8);
    DUPB(9, p9_attn(p, lds, TID));
    if (PH(9)) { p9_attn(p, lds, TID); } SEAM(9);
    DUPB(10, ph_gemm_wo(p, lds, TID, true));
    if (PH(10)) { ph_gemm_wo(p, lds, TID, dryf); } SEAM(10);
    if (PH(11)) { ph_gemm_ffn_in(p, lds, TID, 1); } SEAM(11);
    if (PH(12)) { ph_gemm_ffn_out(p, lds, TID, 1, dryf); } SEAM(12);
    DUPB(13, p13_final_dry(p, TID));
    if (PH(13)) { p13_final(p, TID); }
#undef DUPB
#undef TID
#undef PH
#undef SEAM
}
#ifndef MK_NOPT
#define MK_NOPT 5
#endif
#ifndef MK_DUPSUB
#define MK_DUPSUB 0
#endif
#ifndef MK_ONE
#define MK_ONE 1
#endif
static void naive_tail(int first_stage, void* const* d_in, float* out, char* ws, hipStream_t stream) {
    using namespace nk;
    const float* xp = (const float*)d_in[0]; const float* xs = (const float*)d_in[1]; const float* cp = (const float*)d_in[2]; const float* cs = (const float*)d_in[3];
    const float* w_ada = (const float*)d_in[4]; const float* b_ada = (const float*)d_in[5]; const float* ln_g = (const float*)d_in[6]; const float* ln_b = (const float*)d_in[7];
    const float* lam_re = (const float*)d_in[8]; const float* lam_im = (const float*)d_in[9]; const float* log_dt = (const float*)d_in[10];
    const float* b_re = (const float*)d_in[11]; const float* b_im = (const float*)d_in[12]; const float* c_re = (const float*)d_in[13]; const float* c_im = (const float*)d_in[14];
    const float* s5_d = (const float*)d_in[15]; const float* w_glu = (const float*)d_in[16]; const float* b_glu = (const float*)d_in[17];
    const float* w_qkv = (const float*)d_in[18]; const float* b_qkv = (const float*)d_in[19]; const float* rpb = (const float*)d_in[20]; const float* w_o = (const float*)d_in[21]; const float* b_o = (const float*)d_in[22];
    const float* w_in = (const float*)d_in[23]; const float* b_in = (const float*)d_in[24]; const float* conv_w = (const float*)d_in[25]; const float* conv_b = (const float*)d_in[26];
    const float* w_out = (const float*)d_in[27]; const float* b_out = (const float*)d_in[28];
    const size_t MB = 1ull << 20;
    float* H = (float*)(ws); float* R1 = (float*)(ws + 192 * MB); float* mods = (float*)(ws + 400 * MB);
    const int CH = 4096;
    if (first_stage > 4) return;
    nk_mods<<<48, 256, 0, stream>>>(cp, cs, w_ada, b_ada, mods);
    if (first_stage <= 0) {
        nk_ln_mod<<<NTOK / 4, 256, 0, stream>>>(xp, xs, nullptr, 0, nullptr, nullptr, mods, 0, 1, H);
        float* Y = R1;
        nk_dskip<<<NTOK * D / 256, 256, 0, stream>>>(H, s5_d, Y);
        nk_s5_scan<<<NB * 64, 64, 0, stream>>>(H, Y, 0, lam_re, lam_im, log_dt, b_re, b_im, c_re, c_im);
        nk_s5_scan<<<NB * 64, 64, 0, stream>>>(H, Y, 1, lam_re, lam_im, log_dt, b_re, b_im, c_re, c_im);
        for (int c0 = 0; c0 < NTOK; c0 += CH) { float* AG = H;
            nk_gemm<1><<<dim3(2048 / 64, CH / 64), 256, 0, stream>>>(Y + (size_t)c0 * D, D, w_glu, 2048, b_glu, AG, 2048, CH, 2048, D);
            nk_residual<<<CH / 4, 256, 0, stream>>>(xp, xs, out, 0, nullptr, nullptr, mods, 2, AG, 1, c0, nullptr); }
    }
    for (int layer = 0; layer < 2; ++layer) {
        const float* mods_l = mods + (size_t)layer * NB * 6144;
        if (layer == 1 && first_stage <= 2) {
            const float* lg = ln_g + 1 * D; const float* lb = ln_b + 1 * D;
            nk_ln_mod<<<NTOK / 4, 256, 0, stream>>>(xp, xs, out, 1, lg, lb, mods_l, 0, 1, H);
            float* QKV = R1; float* Oc = R1 + (size_t)80 * MB / 4; float* Yc = R1 + (size_t)100 * MB / 4;
            for (int c0 = 0; c0 < NTOK; c0 += CH) { const int b = tok_b(c0), s0 = seq_start(b), s1 = s0 + seq_len(b);
                int k0 = c0 - 7 * 64; if (k0 < s0) k0 = s0; int k1 = c0 + CH + 7 * 64; if (k1 > s1) k1 = s1; const int kr = k1 - k0;
                nk_gemm<0><<<dim3(3072 / 64, (kr + 63) / 64), 256, 0, stream>>>(H + (size_t)k0 * D, D, w_qkv, 3072, b_qkv, QKV, 3072, kr, 3072, D);
                nk_na_attn<<<CH * 16 / 4, 256, 0, stream>>>(QKV, k0, c0, rpb, Oc);
                nk_gemm<0><<<dim3(D / 64, CH / 64), 256, 0, stream>>>(Oc, D, w_o, D, b_o, Yc, D, CH, D, D);
                nk_residual<<<CH / 4, 256, 0, stream>>>(xp, xs, out, 1, lg, lb, mods_l, 2, Yc, 0, c0, nullptr); }
        }
        if (first_stage > (layer == 0 ? 1 : 3)) continue;
        const float* lg = ln_g + (layer * 2 + 0) * D; const float* lb = ln_b + (layer * 2 + 0) * D;
        nk_ln_mod<<<NTOK / 4, 256, 0, stream>>>(xp, xs, out, 1, lg, lb, mods_l, 3, 4, H);
        float* UG = R1; float* Ac = R1 + (size_t)96 * MB / 4; float* Yc = R1 + (size_t)144 * MB / 4;
        const float* wi = w_in + (size_t)layer * D * 2 * DFF; const float* bi = b_in + (size_t)layer * 2 * DFF;
        const float* cw = conv_w + (size_t)layer * 3 * DFF; const float* cb = conv_b + (size_t)layer * DFF;
        const float* wo = w_out + (size_t)layer * DFF * D; const float* bo = b_out + (size_t)layer * D;
        for (int c0 = 0; c0 < NTOK; c0 += CH) { const int b = tok_b(c0), s0 = seq_start(b), s1 = s0 + seq_len(b);
            int u0 = c0 - 1; if (u0 < s0) u0 = s0; int u1 = c0 + CH + 1; if (u1 > s1) u1 = s1; const int ur = u1 - u0;
            nk_gemm<0><<<dim3(2 * DFF / 64, (ur + 63) / 64), 256, 0, stream>>>(H + (size_t)u0 * D, D, wi, 2 * DFF, bi, UG, 2 * DFF, ur, 2 * DFF, D);
            nk_convgate<<<(CH * DFF + 255) / 256, 256, 0, stream>>>(UG, u0, c0, CH, cw, cb, Ac);
            nk_gemm<0><<<dim3(D / 64, CH / 64), 256, 0, stream>>>(Ac, DFF, wo, D, bo, Yc, D, CH, D, DFF);
            nk_residual<<<CH / 4, 256, 0, stream>>>(xp, xs, out, 1, lg, lb, mods_l, 5, Yc, 0, c0, nullptr); }
    }
    nk_final_ln<<<NTOK / 4, 256, 0, stream>>>(out, ln_g + 3 * D, ln_b + 3 * D);
}

extern "C" void kernel_launch(void* const* d_in, const int* in_sizes, int n_in, void* d_out, int out_size, void* d_ws, size_t ws_size, hipStream_t stream) {
    static int grid = 0;
    if (grid == 0) {
        if (n_in != 29 || out_size != NTOK * D || ws_size < WS_NEED) { fprintf(stderr, "kernel_launch: unexpected problem (n_in %d, out %d, ws %zu < %zu)\n", n_in, out_size, ws_size, (size_t)WS_NEED); grid = -1; return; }
        int dev = 0, cus = 0, per_cu = 0;
        hipGetDevice(&dev); hipDeviceGetAttribute(&cus, hipDeviceAttributeMultiprocessorCount, dev);
        if (hipFuncSetAttribute((const void*)k_fwd, hipFuncAttributeMaxDynamicSharedMemorySize, LDS_BYTES) != hipSuccess) { fprintf(stderr, "kernel_launch: hipFuncSetAttribute failed\n"); grid = -1; return; }
        hipOccupancyMaxActiveBlocksPerMultiprocessor(&per_cu, (const void*)k_fwd, NTHR, LDS_BYTES);
        if (per_cu < 1) { fprintf(stderr, "kernel_launch: occupancy query reports %d blocks per CU\n", per_cu); (void)hipGetLastError(); }
        grid = cus;
    }
    if (grid < 0) return;
    Params p{};
    for (int i = 0; i < 29; ++i) p.in[i] = (const float*)d_in[i];
    p.out = (float*)d_out; p.ws = (unsigned char*)d_ws;
    const int stage_end[6] = {0, 6, 8, 11, 13, 14};
    const int nph = stage_end[MK_NOPT];
    if (nph > 0) {
        (void)hipMemsetAsync((char*)d_ws + WS_CTL, 0, 64 * 1024, stream);
        if (MK_ONE && MK_NOPT == 5) {
            int lo = 0, hi = N_PHASES, fl = 0; void* args[] = {&p, &lo, &hi, &fl};
            hipError_t e = hipLaunchCooperativeKernel((const void*)k_fwd, dim3(grid), dim3(NTHR), args, LDS_BYTES, stream);
            if (e != hipSuccess) fprintf(stderr, "cooperative launch failed: %s (grid %d)\n", hipGetErrorString(e), grid);
        } else {
            for (int ph = 0; ph < nph; ++ph) {
#ifdef MK_DUPL
                if (ph == MK_DUPL) hipLaunchKernelGGL(k_fwd, dim3(grid), dim3(NTHR), LDS_BYTES, stream, p, ph, ph + 1, 1 | (MK_DUPSUB << 8));
#endif
                hipLaunchKernelGGL(k_fwd, dim3(grid), dim3(NTHR), LDS_BYTES, stream, p, ph, ph + 1, 0); }
        }
    }
    naive_tail(MK_NOPT, d_in, (float*)d_out, (char*)d_ws, stream);
}
```
